# Optimizing an MI355X kernel written in HIP

```python
import jax, jax.numpy as jnp
from jax import lax
import numpy as np

D_MODEL = 1024
BATCH = 32
SEQ = 256
DEPTH = 1
DEC_BATCH = 8
DEC_SEQ = 1024
PAST_LEN = 256

GRID_W = 64
MIX_WIDTH = D_MODEL
CONV_WIDTH = MIX_WIDTH // 2
SSD_WIDTH = MIX_WIDTH - CONV_WIDTH
SSD_HEAD_DIM = 64
SSD_HEADS = SSD_WIDTH // SSD_HEAD_DIM
SSD_GROUPS = 2
HEADS_PER_GROUP = SSD_HEADS // SSD_GROUPS
D_STATE = 128
CHUNK = 128
KSIZE = 3
D_FF = 2816
N_MOD = 6
EPS = 1e-6
SSD_CONV_CH = SSD_WIDTH + 2 * SSD_GROUPS * D_STATE
D_IN_PROJ = 3 * CONV_WIDTH + 2 * SSD_WIDTH + 2 * SSD_GROUPS * D_STATE + 2 * SSD_HEADS

kernel_name = "hybrid_shortconv_ssd_convffn_diffusion_step"


def rmsnorm(x, g):
    xf = x.astype(jnp.float32)
    r = lax.rsqrt(jnp.mean(xf * xf, axis=-1, keepdims=True) + EPS)
    return (xf * r).astype(x.dtype) * g


def dwconv1d(x, w, b=None):
    L = x.shape[1]
    xp = jnp.pad(x, ((0, 0), (1, 1), (0, 0)))
    y = xp[:, 0:L] * w[0] + xp[:, 1:L + 1] * w[1] + xp[:, 2:L + 2] * w[2]
    return y if b is None else y + b


def dwconv2d_grid(x, w, b):
    bsz, L, ch = x.shape
    rows = L // GRID_W
    xg = jnp.pad(x.reshape(bsz, rows, GRID_W, ch), ((0, 0), (1, 1), (1, 1), (0, 0)))
    y = b
    for di in range(KSIZE):
        for dj in range(KSIZE):
            y = y + xg[:, di:di + rows, dj:dj + GRID_W] * w[di, dj]
    return y.reshape(bsz, L, ch)


def ssd_scan(x, dt, a, bm, cm, init_state):
    f32 = jnp.float32
    bsz, l = x.shape[0], x.shape[1]
    nc = l // CHUNK
    xdt = x.astype(f32) * dt[..., None]
    bh = jnp.repeat(bm.astype(f32), HEADS_PER_GROUP, axis=2)
    chh = jnp.repeat(cm.astype(f32), HEADS_PER_GROUP, axis=2)
    x_c = xdt.reshape(bsz, nc, CHUNK, SSD_HEADS, SSD_HEAD_DIM)
    b_c = bh.reshape(bsz, nc, CHUNK, SSD_HEADS, D_STATE)
    c_c = chh.reshape(bsz, nc, CHUNK, SSD_HEADS, D_STATE)
    da = (dt * a).reshape(bsz, nc, CHUNK, SSD_HEADS).transpose(0, 3, 1, 2)
    cs = jnp.cumsum(da, axis=-1)
    causal = jnp.tril(jnp.ones((CHUNK, CHUNK), dtype=bool))
    decay_in = jnp.exp(jnp.where(causal, cs[..., :, None] - cs[..., None, :], -jnp.inf))
    scores = jnp.einsum('bclhn,bcshn->bhcls', c_c, b_c) * decay_in
    y_diag = jnp.einsum('bhcls,bcshp->bclhp', scores, x_c)
    decay_to_end = jnp.exp(cs[..., -1:] - cs)
    chunk_states = jnp.einsum('bcshn,bhcs,bcshp->bchpn', b_c, decay_to_end, x_c)
    chunk_decay = jnp.exp(cs[..., -1])

    def step(state, inp):
        dec, add = inp
        return dec[..., None, None] * state + add, state

    final, starts = lax.scan(step, init_state.astype(f32),
                             (jnp.moveaxis(chunk_decay, 2, 0), jnp.moveaxis(chunk_states, 1, 0)))
    y_off = jnp.einsum('bclhn,cbhpn,bhcl->bclhp', c_c, starts, jnp.exp(cs))
    y = (y_diag + y_off).reshape(bsz, l, SSD_HEADS, SSD_HEAD_DIM)
    return y, final


def mixer(h, w_in, w_conv_short, w_conv_ssd, b_conv_ssd, dt_bias, a_log, d_skip,
          g_ssd_norm, w_out, init_f, init_b):
    bsz, l = h.shape[0], h.shape[1]
    proj = h @ w_in
    sizes = [CONV_WIDTH, CONV_WIDTH, CONV_WIDTH, SSD_WIDTH, SSD_CONV_CH, SSD_HEADS, SSD_HEADS]
    offs = [int(v) for v in np.cumsum(sizes)[:-1]]
    hc, gb, gc, z, xbc, dtf, dtb = jnp.split(proj, offs, axis=-1)
    out_a = gb * dwconv1d(gc * hc, w_conv_short)
    xbc = jax.nn.silu(dwconv1d(xbc, w_conv_ssd, b_conv_ssd))
    xs, bm, cm = jnp.split(xbc, [SSD_WIDTH, SSD_WIDTH + SSD_GROUPS * D_STATE], axis=-1)
    xh = xs.reshape(bsz, l, SSD_HEADS, SSD_HEAD_DIM)
    bm = bm.reshape(bsz, l, SSD_GROUPS, D_STATE)
    cm = cm.reshape(bsz, l, SSD_GROUPS, D_STATE)
    dt_f = jax.nn.softplus(dtf.astype(jnp.float32) + dt_bias[0].astype(jnp.float32))
    dt_b = jax.nn.softplus(dtb.astype(jnp.float32) + dt_bias[1].astype(jnp.float32))
    a = -jnp.exp(a_log.astype(jnp.float32))
    y_f, s_f = ssd_scan(xh, dt_f, a[0], bm, cm, init_f)
    y_b_rev, s_b = ssd_scan(xh[:, ::-1], dt_b[:, ::-1], a[1], bm[:, ::-1], cm[:, ::-1], init_b)
    y = y_f + y_b_rev[:, ::-1] + xh.astype(jnp.float32) * d_skip.astype(jnp.float32)[:, None]
    y = y.astype(h.dtype).reshape(bsz, l, SSD_WIDTH)
    y = rmsnorm(y * jax.nn.silu(z), g_ssd_norm)
    out = jnp.concatenate([out_a, y], axis=-1) @ w_out
    return out, s_f.astype(h.dtype), s_b.astype(h.dtype)


def layer(x, mod, is_latent, init_f, init_b, g_norm1, g_norm2, w_in, w_conv_short, w_conv_ssd,
          b_conv_ssd, dt_bias, a_log, d_skip, g_ssd_norm, w_out, w_up, w_ffn_conv, b_ffn_conv, w_down):
    shift_m, scale_m, gate_m = mod[:, :, 0], mod[:, :, 1], mod[:, :, 2]
    shift_f, scale_f, gate_f = mod[:, :, 3], mod[:, :, 4], mod[:, :, 5]
    h = rmsnorm(x, g_norm1) * (1.0 + scale_m) + shift_m
    mix, s_f, s_b = mixer(h, w_in, w_conv_short, w_conv_ssd, b_conv_ssd, dt_bias, a_log, d_skip,
                          g_ssd_norm, w_out, init_f, init_b)
    x = x + gate_m * mix
    h2 = rmsnorm(x, g_norm2) * (1.0 + scale_f) + shift_f
    u = h2 @ w_up
    if is_latent:
        u = dwconv2d_grid(u, w_ffn_conv, b_ffn_conv)
    else:
        u = dwconv1d(u, w_ffn_conv[1], b_ffn_conv)
    ug, uv = jnp.split(u, 2, axis=-1)
    x = x + gate_f * ((jax.nn.silu(ug) * uv) @ w_down)
    return x, s_f, s_b


def setup_inputs(seed: int = 0) -> dict:
    key = jax.random.key(seed)
    ks = jax.random.split(key, 32)
    f32 = jnp.float32
    nrm = lambda k, shp, s: jax.random.normal(k, shp, f32) * s
    dt0 = jnp.exp(jax.random.uniform(ks[14], (DEPTH, 2, SSD_HEADS), f32, np.log(1e-3), np.log(1e-1)))
    return {
        "x_prompt": nrm(ks[0], (BATCH, SEQ, D_MODEL), 1.0),
        "x_sample": nrm(ks[1], (DEC_BATCH, DEC_SEQ, D_MODEL), 1.0),
        "state_ssd_fwd": nrm(ks[2], (DEC_BATCH, DEPTH, SSD_HEADS, SSD_HEAD_DIM, D_STATE), 0.5),
        "state_ssd_bwd": nrm(ks[3], (DEC_BATCH, DEPTH, SSD_HEADS, SSD_HEAD_DIM, D_STATE), 0.5),
        "c": nrm(ks[4], (DEC_BATCH, D_MODEL), 1.0),
        "c_ctx": nrm(ks[5], (D_MODEL,), 1.0),
        "g_norm1": 1.0 + nrm(ks[6], (DEPTH, D_MODEL), 0.02),
        "g_norm2": 1.0 + nrm(ks[7], (DEPTH, D_MODEL), 0.02),
        "w_ada": nrm(ks[8], (DEPTH, D_MODEL, N_MOD * D_MODEL), 0.5 * D_MODEL ** -0.5),
        "b_ada": nrm(ks[9], (DEPTH, N_MOD * D_MODEL), 0.02),
        "w_in": nrm(ks[10], (DEPTH, D_MODEL, D_IN_PROJ), D_MODEL ** -0.5),
        "w_conv_short": nrm(ks[11], (DEPTH, KSIZE, CONV_WIDTH), KSIZE ** -0.5),
        "w_conv_ssd": nrm(ks[12], (DEPTH, KSIZE, SSD_CONV_CH), KSIZE ** -0.5),
        "b_conv_ssd": nrm(ks[13], (DEPTH, SSD_CONV_CH), 0.02),
        "dt_bias": jnp.log(jnp.expm1(dt0)),
        "a_log": jnp.log(jax.random.uniform(ks[15], (DEPTH, 2, SSD_HEADS), f32, 1.0, 16.0)),
        "d_skip": 1.0 + nrm(ks[16], (DEPTH, SSD_HEADS), 0.1),
        "g_ssd_norm": 1.0 + nrm(ks[17], (DEPTH, SSD_WIDTH), 0.02),
        "w_out": nrm(ks[18], (DEPTH, MIX_WIDTH, D_MODEL), MIX_WIDTH ** -0.5),
        "w_up": nrm(ks[19], (DEPTH, D_MODEL, 2 * D_FF), D_MODEL ** -0.5),
        "w_ffn_conv": nrm(ks[20], (DEPTH, KSIZE, KSIZE, 2 * D_FF), KSIZE ** -1.0),
        "b_ffn_conv": nrm(ks[21], (DEPTH, 2 * D_FF), 0.02),
        "w_down": nrm(ks[22], (DEPTH, D_FF, D_MODEL), D_FF ** -0.5),
        "g_final": 1.0 + nrm(ks[23], (D_MODEL,), 0.02),
    }


def reference(x_prompt, x_sample, state_ssd_fwd, state_ssd_bwd, c, c_ctx, g_norm1, g_norm2,
              w_ada, b_ada, w_in, w_conv_short, w_conv_ssd, b_conv_ssd, dt_bias, a_log, d_skip,
              g_ssd_norm, w_out, w_up, w_ffn_conv, b_ffn_conv, w_down, g_final):
    xp = x_prompt
    xs = x_sample
    bp = x_prompt.shape[0]
    zero_state = jnp.zeros((bp, SSD_HEADS, SSD_HEAD_DIM, D_STATE), x_prompt.dtype)
    new_f, new_b = [], []
    for i in range(DEPTH):
        mod_ctx = (jax.nn.silu(c_ctx)[None] @ w_ada[i] + b_ada[i]).reshape(1, 1, N_MOD, D_MODEL)
        mod_lat = (jax.nn.silu(c) @ w_ada[i] + b_ada[i]).reshape(c.shape[0], 1, N_MOD, D_MODEL)
        wl = (g_norm1[i], g_norm2[i], w_in[i], w_conv_short[i], w_conv_ssd[i], b_conv_ssd[i],
              dt_bias[i], a_log[i], d_skip[i], g_ssd_norm[i], w_out[i], w_up[i], w_ffn_conv[i],
              b_ffn_conv[i], w_down[i])
        xp, s_f, s_b = layer(xp, mod_ctx, False, zero_state, zero_state, *wl)
        new_f.append(s_f)
        new_b.append(s_b)
        xs, _, _ = layer(xs, mod_lat, True, state_ssd_fwd[:, i], state_ssd_bwd[:, i], *wl)
    y_prompt = rmsnorm(xp, g_final)
    y_sample = rmsnorm(xs, g_final)
    new_state_ssd_fwd = jnp.stack(new_f, axis=1)
    new_state_ssd_bwd = jnp.stack(new_b, axis=1)
    return (y_prompt, y_sample, new_state_ssd_fwd, new_state_ssd_bwd)
```

```cpp
#include <hip/hip_runtime.h>
#include <cstdio>
#include <cstdint>

namespace nv {
constexpr int D = 1024, NPROJ = 3088, DFF = 2816, NUP = 5632, NMOD = 6;
constexpr float EPS = 1e-6f;

__device__ __forceinline__ float silu_f(float x) { return x / (1.f + __expf(-x)); }
__device__ __forceinline__ float softplus_f(float x) { return fmaxf(x, 0.f) + log1pf(__expf(-fabsf(x))); }

__device__ __forceinline__ float block_sum_256(float v, float* red) {
    for (int o = 32; o > 0; o >>= 1) v += __shfl_xor(v, o);
    const int w = threadIdx.x >> 6, l = threadIdx.x & 63;
    __syncthreads();
    if (l == 0) red[w] = v;
    __syncthreads();
    return red[0] + red[1] + red[2] + red[3];
}

__global__ void k_mod(const float* c, const float* c_ctx, const float* w_ada, const float* b_ada, float* mod) {
    const int mb = blockIdx.y, j = blockIdx.x * 256 + threadIdx.x;
    const float* cv = mb == 0 ? c_ctx : c + (mb - 1) * D;
    float acc = b_ada[j];
    for (int k = 0; k < D; ++k) acc += silu_f(cv[k]) * w_ada[(size_t)k * (NMOD * D) + j];
    mod[mb * NMOD * D + j] = acc;
}

__global__ void k_norm_mod(const float* x, const float* g, const float* mod, int mb0, int rows_per_mb, int i_shift, int i_scale, float* out) {
    __shared__ float red[4];
    const int row = blockIdx.x; const float* xr = x + (size_t)row * D;
    float v[4]; float s = 0.f;
    for (int i = 0; i < 4; ++i) { v[i] = xr[threadIdx.x + 256 * i]; s += v[i] * v[i]; }
    s = block_sum_256(s, red);
    const float r = rsqrtf(s / D + EPS);
    const int mb = mb0 + (rows_per_mb ? row / rows_per_mb : 0);
    for (int i = 0; i < 4; ++i) { const int c = threadIdx.x + 256 * i; float o = (v[i] * r) * g[c];
        if (mod) o = o * (1.f + mod[(mb * NMOD + i_scale) * D + c]) + mod[(mb * NMOD + i_shift) * D + c];
        out[(size_t)row * D + c] = o; }
}

__global__ void k_gemm(const float* A, int lda, const float* W, int ldw, float* C, int ldc, int M, int N, int K) {
    __shared__ float As[16][65], Ws[16][65];
    const int tx = threadIdx.x & 15, ty = threadIdx.x >> 4, m0 = blockIdx.y * 64, n0 = blockIdx.x * 64;
    float acc[4][4] = {};
    for (int k0 = 0; k0 < K; k0 += 16) {
        for (int i = threadIdx.x; i < 64 * 16; i += 256) { const int r = i >> 4, kk = i & 15; As[kk][r] = A[(size_t)(m0 + r) * lda + k0 + kk]; }
        for (int i = threadIdx.x; i < 64 * 16; i += 256) { const int kk = i >> 6, cidx = i & 63; Ws[kk][cidx] = (n0 + cidx < N) ? W[(size_t)(k0 + kk) * ldw + n0 + cidx] : 0.f; }
        __syncthreads();
#pragma unroll
        for (int kk = 0; kk < 16; ++kk) { float a[4], b[4];
#pragma unroll
            for (int i = 0; i < 4; ++i) { a[i] = As[kk][ty * 4 + i]; b[i] = Ws[kk][tx * 4 + i]; }
#pragma unroll
            for (int i = 0; i < 4; ++i)
#pragma unroll
                for (int j = 0; j < 4; ++j) acc[i][j] += a[i] * b[j]; }
        __syncthreads();
    }
    for (int i = 0; i < 4; ++i) for (int j = 0; j < 4; ++j) { const int n = n0 + tx * 4 + j; if (n < N) C[(size_t)(m0 + ty * 4 + i) * ldc + n] = acc[i][j]; }
}

__global__ void k_mix(const float* proj, int L, const float* w_short, const float* w_ssd, const float* b_ssd, const float* dt_bias, float* mixA, float* xc, float* dt) {
    const int row = blockIdx.x, t = row % L;
    const float* p1 = proj + (size_t)row * NPROJ; const float* p0 = t > 0 ? p1 - NPROJ : nullptr; const float* p2 = t < L - 1 ? p1 + NPROJ : nullptr;
    for (int c = threadIdx.x; c < 512; c += 256) {
        float a = 0.f;
        if (p0) a += w_short[0 * 512 + c] * (p0[1024 + c] * p0[c]);
        a += w_short[1 * 512 + c] * (p1[1024 + c] * p1[c]);
        if (p2) a += w_short[2 * 512 + c] * (p2[1024 + c] * p2[c]);
        mixA[(size_t)row * D + c] = p1[512 + c] * a;
    }
    for (int c = threadIdx.x; c < 1024; c += 256) {
        float a = b_ssd[c];
        if (p0) a += w_ssd[0 * 1024 + c] * p0[2048 + c];
        a += w_ssd[1 * 1024 + c] * p1[2048 + c];
        if (p2) a += w_ssd[2 * 1024 + c] * p2[2048 + c];
        xc[(size_t)row * 1024 + c] = silu_f(a);
    }
    if (threadIdx.x < 16) dt[(size_t)row * 16 + threadIdx.x] = softplus_f(p1[3072 + threadIdx.x] + dt_bias[threadIdx.x]);
}

__global__ void __launch_bounds__(64) k_ssd(const float* xc, const float* dt, const float* a_log, int L, const float* init_f, const float* init_b, float* ydir, size_t ydir_stride, float* st_f, float* st_b) {
    __shared__ float BC[256];
    const int dir = blockIdx.x & 1, h = (blockIdx.x >> 1) & 7, seq = blockIdx.x >> 4, p = threadIdx.x, g = h >> 2;
    const float a = -__expf(a_log[dir * 8 + h]);
    float st[128];
    const float* init = dir ? init_b : init_f;
#pragma unroll
    for (int n = 0; n < 128; ++n) st[n] = init ? init[(((size_t)seq * 8 + h) * 64 + p) * 128 + n] : 0.f;
    for (int i = 0; i < L; ++i) {
        const int t = dir ? L - 1 - i : i; const size_t row = (size_t)seq * L + t;
        __syncthreads();
        for (int j = p; j < 256; j += 64) BC[j] = xc[row * 1024 + 512 + (j >> 7) * 256 + g * 128 + (j & 127)];
        __syncthreads();
        const float dtv = dt[row * 16 + dir * 8 + h], dA = __expf(dtv * a), xv = xc[row * 1024 + h * 64 + p] * dtv;
        float y = 0.f;
#pragma unroll
        for (int n = 0; n < 128; ++n) { st[n] = dA * st[n] + xv * BC[n]; y += BC[128 + n] * st[n]; }
        ydir[dir * ydir_stride + row * 512 + h * 64 + p] = y;
    }
    float* so = dir ? st_b : st_f;
    if (so) {
#pragma unroll
        for (int n = 0; n < 128; ++n) so[(((size_t)seq * 8 + h) * 64 + p) * 128 + n] = st[n];
    }
}

__global__ void k_ynorm(const float* ydir, size_t ydir_stride, const float* xc, const float* proj, const float* d_skip, const float* g_ssd, float* mixA) {
    __shared__ float red[4];
    const int row = blockIdx.x; float v[2]; float s = 0.f;
    for (int i = 0; i < 2; ++i) { const int c = threadIdx.x + 256 * i;
        float y = ydir[(size_t)row * 512 + c] + ydir[ydir_stride + (size_t)row * 512 + c] + xc[(size_t)row * 1024 + c] * d_skip[c >> 6];
        y *= silu_f(proj[(size_t)row * NPROJ + 1536 + c]); v[i] = y; s += y * y; }
    s = block_sum_256(s, red);
    const float r = rsqrtf(s / 512.f + EPS);
    for (int i = 0; i < 2; ++i) { const int c = threadIdx.x + 256 * i; mixA[(size_t)row * D + 512 + c] = (v[i] * r) * g_ssd[c]; }
}

__global__ void k_resid(const float* x, const float* o, const float* mod, int mb0, int rows_per_mb, int i_gate, float* x1) {
    const int row = blockIdx.x; const int mb = mb0 + (rows_per_mb ? row / rows_per_mb : 0);
    for (int c = threadIdx.x; c < D; c += 256) x1[(size_t)row * D + c] = x[(size_t)row * D + c] + mod[(mb * NMOD + i_gate) * D + c] * o[(size_t)row * D + c];
}

__global__ void k_ffnconv(const float* u, int L, int latent, const float* w, const float* b, float* gout) {
    const int row = blockIdx.x, t = row % L; const float* u1 = u + (size_t)row * NUP;
    for (int c = threadIdx.x; c < DFF; c += 256) {
        float r2[2];
        for (int hh = 0; hh < 2; ++hh) { const int cc = c + hh * DFF; float a = b[cc];
            if (latent) { const int gr = t >> 6, gc = t & 63;
                for (int di = 0; di < 3; ++di) for (int dj = 0; dj < 3; ++dj) { const int rr = gr + di - 1, c2 = gc + dj - 1;
                    if (rr >= 0 && rr < 16 && c2 >= 0 && c2 < 64) a += u1[(ptrdiff_t)((rr - gr) * 64 + (c2 - gc)) * NUP + cc] * w[(di * 3 + dj) * NUP + cc]; }
            } else {
                if (t > 0) a += u1[-NUP + cc] * w[(3 + 0) * NUP + cc];
                a += u1[cc] * w[(3 + 1) * NUP + cc];
                if (t < L - 1) a += u1[NUP + cc] * w[(3 + 2) * NUP + cc];
            }
            r2[hh] = a; }
        gout[(size_t)row * DFF + c] = silu_f(r2[0]) * r2[1];
    }
}

struct Pass { const float* x; int nseq, L, latent, mb0, rows_per_mb; const float *init_f, *init_b; float *y, *st_f, *st_b; };

static void run(void* const* d_in, float* d_out, float* ws, hipStream_t s) {
    const float *x_prompt = (const float*)d_in[0], *x_sample = (const float*)d_in[1], *sf = (const float*)d_in[2], *sb = (const float*)d_in[3], *c = (const float*)d_in[4], *c_ctx = (const float*)d_in[5],
        *g1 = (const float*)d_in[6], *g2 = (const float*)d_in[7], *w_ada = (const float*)d_in[8], *b_ada = (const float*)d_in[9], *w_in = (const float*)d_in[10], *w_cs = (const float*)d_in[11],
        *w_cssd = (const float*)d_in[12], *b_cssd = (const float*)d_in[13], *dt_bias = (const float*)d_in[14], *a_log = (const float*)d_in[15], *d_skip = (const float*)d_in[16], *g_ssd = (const float*)d_in[17],
        *w_out = (const float*)d_in[18], *w_up = (const float*)d_in[19], *w_fc = (const float*)d_in[20], *b_fc = (const float*)d_in[21], *w_down = (const float*)d_in[22], *g_final = (const float*)d_in[23];
    const size_t R = 8192;
    float* mod = ws;
    float* bufA = ws + 65536;
    float* proj = bufA + R * 1024;
    float* xc = proj + R * NPROJ;
    float* mixA = xc + R * 1024;
    float* dtb = mixA + R * 1024;
    float* ydir = dtb + R * 16;
    float* ubuf = proj;
    float* gbuf = ydir + 2 * R * 512;
    float* dn = gbuf + (size_t)2048 * DFF;
    k_mod<<<dim3(NMOD * D / 256, 9), 256, 0, s>>>(c, c_ctx, w_ada, b_ada, mod);
    Pass ps[2] = { {x_prompt, 32, 256, 0, 0, 0, nullptr, nullptr, d_out, d_out + 2 * R * 1024, d_out + 2 * R * 1024 + 2097152},
                   {x_sample, 8, 1024, 1, 1, 1024, sf, sb, d_out + R * 1024, nullptr, nullptr} };
    for (int pi = 0; pi < 2; ++pi) { const Pass& P = ps[pi];
        k_norm_mod<<<R, 256, 0, s>>>(P.x, g1, mod, P.mb0, P.rows_per_mb, 0, 1, bufA);
        k_gemm<<<dim3((NPROJ + 63) / 64, R / 64), 256, 0, s>>>(bufA, 1024, w_in, NPROJ, proj, NPROJ, R, NPROJ, 1024);
        k_mix<<<R, 256, 0, s>>>(proj, P.L, w_cs, w_cssd, b_cssd, dt_bias, mixA, xc, dtb);
        k_ssd<<<P.nseq * 16, 64, 0, s>>>(xc, dtb, a_log, P.L, P.init_f, P.init_b, ydir, R * 512, P.st_f, P.st_b);
        k_ynorm<<<R, 256, 0, s>>>(ydir, R * 512, xc, proj, d_skip, g_ssd, mixA);
        k_gemm<<<dim3(1024 / 64, R / 64), 256, 0, s>>>(mixA, 1024, w_out, 1024, bufA, 1024, R, 1024, 1024);
        k_resid<<<R, 256, 0, s>>>(P.x, bufA, mod, P.mb0, P.rows_per_mb, 2, P.y);
        k_norm_mod<<<R, 256, 0, s>>>(P.y, g2, mod, P.mb0, P.rows_per_mb, 3, 4, bufA);
        for (int rb = 0; rb < 4; ++rb) { const size_t r0 = rb * 2048;
            k_gemm<<<dim3(NUP / 64, 2048 / 64), 256, 0, s>>>(bufA + r0 * 1024, 1024, w_up, NUP, ubuf, NUP, 2048, NUP, 1024);
            k_ffnconv<<<2048, 256, 0, s>>>(ubuf, P.L, P.latent, w_fc, b_fc, gbuf);
            k_gemm<<<dim3(1024 / 64, 2048 / 64), 256, 0, s>>>(gbuf, DFF, w_down, 1024, dn, 1024, 2048, 1024, DFF);
            const int mb0 = P.mb0 + (P.rows_per_mb ? (int)(r0 / P.rows_per_mb) : 0);
            k_resid<<<2048, 256, 0, s>>>(P.y + r0 * 1024, dn, mod, mb0, P.rows_per_mb, 5, P.y + r0 * 1024);
        }
        k_norm_mod<<<R, 256, 0, s>>>(P.y, g_final, nullptr, 0, 0, 0, 0, P.y);
    }
}
}

extern "C" void kernel_launch(void* const* d_in, const int* in_sizes, int n_in, void* d_out, int out_size, void* d_ws, size_t ws_size, hipStream_t stream) {
    nv::run(d_in, (float*)d_out, (float*)d_ws, stream);
}
```

```cpp
#include <hip/hip_runtime.h>
#include <cstdio>
#include <cstdint>
namespace pg8 {
#define PG8_LAS __attribute__((address_space(3)))
typedef unsigned short bf16_t;
typedef short bf16x8 __attribute__((ext_vector_type(8)));
typedef float f32x4 __attribute__((ext_vector_type(4)));
typedef unsigned u32x4 __attribute__((ext_vector_type(4)));
constexpr int BM = 256, BK = 64, HALF = 128, HTB = HALF * BK * 2  , STAGE_BYTES = 8 * HTB, NXCD = 8, WGM = 8;

__host__ __device__ __forceinline__ int lds_byte(int r, int c) { const int st = (r >> 4) * 2 + (c >> 5), rr = r & 15, cc = c & 31, ob = rr * 64 + cc * 2; return st * 1024 + (ob ^ (((ob >> 9) & 1) << 5)); }
__host__ __device__ __forceinline__ void stage_rc(int b, int& R, int& C) { const int st = b / 1024, sb = b % 1024, swz = sb ^ (((sb >> 9) & 1) << 5); R = (st >> 1) * 16 + swz / 64; C = (st & 1) * 32 + (swz % 64) / 2; }
__host__ __device__ __forceinline__ int perm32(int rho) { const int n = rho >> 4, i = rho & 15; return 8 * (i >> 2) + 4 * n + (i & 3); }

struct Unit { int pm, pn; };
struct Gemm { const bf16_t* A; const bf16_t* Bt; int M, N, K; };

struct StaticOrder {
    int nM, nN, nwg, G, c;
    __host__ __device__ void init(int M, int N, int G_, int c_) { nM = M / BM; nN = N / BM; nwg = nM * nN; G = G_; c = c_; }
    __host__ __device__ bool next(int i, Unit& u) const {
        const long L = (long)i * G + c; if (L >= nwg) return false;
        int wgid = (int)L; { const int q = nwg / NXCD, r = nwg % NXCD, xcd = wgid % NXCD, off = wgid / NXCD; wgid = (xcd < r ? xcd * (q + 1) : r * (q + 1) + (xcd - r) * q) + off; }
        const int nig = WGM * nN, gid = wgid / nig, fm = gid * WGM, gsz = (nM - fm) < WGM ? (nM - fm) : WGM;
        u.pm = fm + ((wgid % nig) % gsz); u.pn = (wgid % nig) / gsz; return true;
    }
    __device__ __forceinline__ void a_ready(const Unit&) const {}
    __device__ __forceinline__ void done(const Unit&) const {}
};

__device__ __forceinline__ unsigned cvt_pk_bf16(float lo, float hi) { unsigned r; asm volatile("v_cvt_pk_bf16_f32 %0, %1, %2" : "=v"(r) : "v"(lo), "v"(hi)); return r; }
constexpr float RMS_EPS = 1e-6f;
__device__ __forceinline__ int mb_of_tile(int gpm) { return gpm < 32 ? 0 : 1 + ((gpm - 32) >> 2); }

struct EpiPlainBf16 {
    static constexpr bool PERM = true, AFTER_DRAIN = false; static constexpr int MID_T = -1;
    bf16_t* O; int ldc;
    __device__ __forceinline__ void mid(f32x4 (&)[2][2][4][2], const Unit&, int, int) const {}
    __device__ __forceinline__ void operator()(const f32x4 (&acc)[2][2][4][2], const Unit& u, int wr, int wc, int fr, int fq) const {
        const int row0 = u.pm * BM + wr * 64 + fr, col0 = u.pn * BM + wc * 32 + 8 * fq;
#pragma unroll
        for (int ai = 0; ai < 2; ++ai)
#pragma unroll
            for (int m = 0; m < 4; ++m) { bf16_t* rowp = O + (size_t)(row0 + ai * HALF + m * 16) * ldc + col0;
#pragma unroll
                for (int bj = 0; bj < 2; ++bj) { const f32x4 v0 = acc[ai][bj][m][0], v1 = acc[ai][bj][m][1];
                    u32x4 w; w.x = cvt_pk_bf16(v0[0], v0[1]); w.y = cvt_pk_bf16(v0[2], v0[3]); w.z = cvt_pk_bf16(v1[0], v1[1]); w.w = cvt_pk_bf16(v1[2], v1[3]);
                    *(u32x4*)(rowp + bj * HALF) = w; } }
    }
};

struct EpiUp {
    static constexpr bool PERM = true, AFTER_DRAIN = false; static constexpr int MID_T = -1;
    bf16_t* O; const float* ssq; const float* sv; int tile0;
    __device__ __forceinline__ void mid(f32x4 (&)[2][2][4][2], const Unit&, int, int) const {}
    __device__ __forceinline__ void operator()(const f32x4 (&acc)[2][2][4][2], const Unit& u, int wr, int wc, int fr, int fq) const {
        const int gpm = tile0 + u.pm, mb = mb_of_tile(gpm);
        const int lrow0 = u.pm * BM + wr * 64 + fr, col0 = u.pn * BM + wc * 32 + 8 * fq;
        f32x4 bv[2][2];
#pragma unroll
        for (int bj = 0; bj < 2; ++bj)
#pragma unroll
            for (int n = 0; n < 2; ++n) bv[bj][n] = *(const f32x4*)(sv + (size_t)mb * 5632 + col0 + bj * HALF + 4 * n);
#pragma unroll
        for (int ai = 0; ai < 2; ++ai)
#pragma unroll
            for (int m = 0; m < 4; ++m) { const int lrow = lrow0 + ai * HALF + m * 16;
                const float r = __builtin_amdgcn_rsqf(ssq[(size_t)tile0 * BM + lrow] * (1.0f / 1024.0f) + RMS_EPS);
                bf16_t* rowp = O + (size_t)lrow * 5632 + col0;
#pragma unroll
                for (int bj = 0; bj < 2; ++bj) { const f32x4 v0 = acc[ai][bj][m][0] * r + bv[bj][0], v1 = acc[ai][bj][m][1] * r + bv[bj][1];
                    u32x4 w; w.x = cvt_pk_bf16(v0[0], v0[1]); w.y = cvt_pk_bf16(v0[2], v0[3]); w.z = cvt_pk_bf16(v1[0], v1[1]); w.w = cvt_pk_bf16(v1[2], v1[3]);
                    *(u32x4*)(rowp + bj * HALF) = w; } }
    }
};

struct EpiOut {
    static constexpr bool PERM = false, AFTER_DRAIN = false; static constexpr int MID_T = 8;
    const float* xp; const float* xs; float* x1; bf16_t* A2; const float* modz; const float* b_ada; const float* g2; float* ssq2; const float* ssqy;
    __device__ __forceinline__ void mid(f32x4 (&acc)[2][2][4][2], const Unit& u, int wr, int fr) const {
#pragma unroll
        for (int ai = 0; ai < 2; ++ai)
#pragma unroll
            for (int m = 0; m < 4; ++m) { const int row = u.pm * BM + ai * HALF + wr * 64 + m * 16 + fr;
                const float ry = __builtin_amdgcn_rsqf(ssqy[row] * (1.0f / 512.0f) + RMS_EPS);
#pragma unroll
                for (int bj = 0; bj < 2; ++bj)
#pragma unroll
                    for (int n = 0; n < 2; ++n) acc[ai][bj][m][n] = acc[ai][bj][m][n] * ry; }
    }
    __device__ __forceinline__ void operator()(const f32x4 (&acc)[2][2][4][2], const Unit& u, int wr, int wc, int fr, int fq) const {
        const int mb = mb_of_tile(u.pm), col0 = u.pn * BM + wc * 32 + 4 * fq;
        f32x4 gate[2][2], gs[2][2];
#pragma unroll
        for (int bj = 0; bj < 2; ++bj)
#pragma unroll
            for (int n = 0; n < 2; ++n) { const int c = col0 + bj * HALF + n * 16;
                gate[bj][n] = *(const f32x4*)(modz + mb * 6144 + 2 * 1024 + c) + *(const f32x4*)(b_ada + 2 * 1024 + c);
                gs[bj][n] = *(const f32x4*)(g2 + c) * (*(const f32x4*)(modz + mb * 6144 + 4 * 1024 + c) + *(const f32x4*)(b_ada + 4 * 1024 + c) + 1.0f); }
#pragma unroll
        for (int ai = 0; ai < 2; ++ai)
#pragma unroll
            for (int m = 0; m < 4; ++m) { const int row = u.pm * BM + ai * HALF + wr * 64 + m * 16 + fr;
                const float* xr = row < 8192 ? xp + (size_t)row * 1024 : xs + (size_t)(row - 8192) * 1024;
                float sq = 0.f;
#pragma unroll
                for (int bj = 0; bj < 2; ++bj)
#pragma unroll
                    for (int n = 0; n < 2; ++n) { const int c = col0 + bj * HALF + n * 16;
                        const f32x4 v = *(const f32x4*)(xr + c) + gate[bj][n] * acc[ai][bj][m][n];
                        *(f32x4*)(x1 + (size_t)row * 1024 + c) = v;
                        sq += (v[0] * v[0] + v[1] * v[1]) + (v[2] * v[2] + v[3] * v[3]);
                        const f32x4 a = v * gs[bj][n];
                        typedef unsigned u32x2v __attribute__((ext_vector_type(2)));
                        u32x2v w; w.x = cvt_pk_bf16(a[0], a[1]); w.y = cvt_pk_bf16(a[2], a[3]);
                        *(u32x2v*)(A2 + (size_t)row * 1024 + c) = w; }
                sq += __shfl_xor(sq, 16); sq += __shfl_xor(sq, 32);
                if (fq == 0) atomicAdd(ssq2 + row, sq); }
    }
};

struct EpiDown {
    static constexpr bool PERM = false, AFTER_DRAIN = false; static constexpr int MID_T = -1;
    float* x1; const float* modz; const float* b_ada; float* ssq3;
    __device__ __forceinline__ void mid(f32x4 (&)[2][2][4][2], const Unit&, int, int) const {}
    __device__ __forceinline__ void operator()(const f32x4 (&acc)[2][2][4][2], const Unit& u, int wr, int wc, int fr, int fq) const {
        const int mb = mb_of_tile(u.pm), col0 = u.pn * BM + wc * 32 + 4 * fq;
        f32x4 gate[2][2];
#pragma unroll
        for (int bj = 0; bj < 2; ++bj)
#pragma unroll
            for (int n = 0; n < 2; ++n) { const int c = col0 + bj * HALF + n * 16;
                gate[bj][n] = *(const f32x4*)(modz + mb * 6144 + 5 * 1024 + c) + *(const f32x4*)(b_ada + 5 * 1024 + c); }
#pragma unroll
        for (int ai = 0; ai < 2; ++ai)
#pragma unroll
            for (int m = 0; m < 4; ++m) { const int row = u.pm * BM + ai * HALF + wr * 64 + m * 16 + fr;
                float sq = 0.f;
#pragma unroll
                for (int bj = 0; bj < 2; ++bj)
#pragma unroll
                    for (int n = 0; n < 2; ++n) { const int c = col0 + bj * HALF + n * 16;
                        float* p = x1 + (size_t)row * 1024 + c;
                        const f32x4 v = *(const f32x4*)p + gate[bj][n] * acc[ai][bj][m][n];
                        *(f32x4*)p = v;
                        sq += (v[0] * v[0] + v[1] * v[1]) + (v[2] * v[2] + v[3] * v[3]); }
                sq += __shfl_xor(sq, 16); sq += __shfl_xor(sq, 32);
                if (fq == 0) atomicAdd(ssq3 + row, sq); }
    }
};
template <class Epi, class Sched, bool ALIGN_EPI = false, bool SP2 = false>
__device__ __forceinline__ void gemm_phase(PG8_LAS unsigned char* lds, const Gemm g, const Sched& S, const Epi& E) {
    int tid_ = threadIdx.x; asm volatile("" : "+v"(tid_)); const int tid = tid_, wid = __builtin_amdgcn_readfirstlane(tid >> 6), lane = tid & 63, wr = wid >> 2, wc = wid & 3, fr = lane & 15, fq = lane >> 4;
    const int K = g.K, nt = K / BK;
    unsigned voffA[2], voffB[2];
#pragma unroll
    for (int i = 0; i < 2; ++i) { int R, C; stage_rc(tid * 16 + i * 8192, R, C); const int Rb = Epi::PERM ? ((R & ~31) + perm32(R & 31)) : R;
        voffA[i] = (unsigned)(R * K + C) * 2u; voffB[i] = (unsigned)(Rb * K + C) * 2u; }
    const size_t kstep = (size_t)(BK * 2);
    const size_t hstep = (size_t)HALF * K * 2;
    const size_t tstep = 2 * hstep;
    const unsigned ldsw = (unsigned)wid * 1024u;
    const int aoff = lds_byte(wr * 64 + fr, fq * 8), boff = lds_byte(wc * 32 + fr, fq * 8);
#define PG8_SA(b, h) (((b) * 2 + (h)) * HTB)
#define PG8_SB(b, h) ((4 + (b) * 2 + (h)) * HTB)
#define PG8_STAGE(bufoff, gbase, voff) do { _Pragma("unroll") for (int _i = 0; _i < 2; ++_i) \
        __builtin_amdgcn_global_load_lds((const unsigned*)((const char*)(gbase) + (voff)[_i]), (PG8_LAS unsigned*)(lds + (bufoff) + ldsw + _i * 8192), 16, 0, 0); } while (0)
#define PG8_LDA(dst, b, h) do { _Pragma("unroll") for (int m = 0; m < 4; ++m) _Pragma("unroll") for (int k = 0; k < 2; ++k) dst[m][k] = *(const PG8_LAS bf16x8*)(lds + PG8_SA(b, h) + aoff + m * 2048 + k * 1024); } while (0)
#define PG8_LDB(dst, b, h) do { _Pragma("unroll") for (int n = 0; n < 2; ++n) _Pragma("unroll") for (int k = 0; k < 2; ++k) dst[n][k] = *(const PG8_LAS bf16x8*)(lds + PG8_SB(b, h) + boff + n * 2048 + k * 1024); } while (0)
#define PG8_MMA(ai, bj, At, Bt) do { __builtin_amdgcn_s_setprio(1); _Pragma("unroll") for (int m = 0; m < 4; ++m) _Pragma("unroll") for (int n = 0; n < 2; ++n) _Pragma("unroll") for (int k = 0; k < 2; ++k) \
        acc[ai][bj][m][n] = __builtin_amdgcn_mfma_f32_16x16x32_bf16(Bt[n][k], At[m][k], acc[ai][bj][m][n], 0, 0, 0); __builtin_amdgcn_s_setprio(0); } while (0)
#define PG8_WAIT_V(n) asm volatile("s_waitcnt vmcnt(" #n ")" ::: "memory")
#define PG8_WAIT_L(n) asm volatile("s_waitcnt lgkmcnt(" #n ")" ::: "memory")
#define PG8_BAR __builtin_amdgcn_s_barrier()
#define PG8_SCHED __builtin_amdgcn_sched_barrier(0)
    Unit cur, nxt; int ui = 0;
    if (!S.next(0, cur)) return;
    f32x4 acc[2][2][4][2];
#pragma unroll
    for (int a = 0; a < 2; ++a)
#pragma unroll
        for (int b = 0; b < 2; ++b)
#pragma unroll
            for (int m = 0; m < 4; ++m)
#pragma unroll
                for (int n = 0; n < 2; ++n) acc[a][b][m][n] = (f32x4){0.f, 0.f, 0.f, 0.f};
    bf16x8 At[4][2], B0[2][2], B1[2][2];
    const char* cA = (const char*)g.A + (size_t)cur.pm * tstep; const char* cB = (const char*)g.Bt + (size_t)cur.pn * tstep;
    S.a_ready(cur);
    if constexpr (SP2) {
        PG8_STAGE(PG8_SB(0, 0), cB, voffB); PG8_STAGE(PG8_SB(0, 1), cB + hstep, voffB); PG8_STAGE(PG8_SA(0, 0), cA, voffA); PG8_STAGE(PG8_SA(0, 1), cA + hstep, voffA);
        if (wr == 1) PG8_BAR;
        PG8_WAIT_V(2); PG8_BAR;
        PG8_STAGE(PG8_SB(1, 0), cB + kstep, voffB); PG8_STAGE(PG8_SA(1, 0), cA + kstep, voffA); PG8_STAGE(PG8_SB(1, 1), cB + hstep + kstep, voffB);
        PG8_WAIT_V(6); PG8_BAR;
    } else {
        PG8_STAGE(PG8_SB(0, 0), cB, voffB); PG8_STAGE(PG8_SA(0, 0), cA, voffA); PG8_STAGE(PG8_SB(0, 1), cB + hstep, voffB); PG8_STAGE(PG8_SA(0, 1), cA + hstep, voffA);
        if (wr == 1) PG8_BAR;
        PG8_WAIT_V(4); PG8_BAR;
        PG8_STAGE(PG8_SB(1, 0), cB + kstep, voffB); PG8_STAGE(PG8_SA(1, 0), cA + kstep, voffA); PG8_STAGE(PG8_SB(1, 1), cB + hstep + kstep, voffB);
        PG8_WAIT_V(6); PG8_BAR;
    }
    for (;;) {
        const bool has_next = S.next(ui + 1, nxt);
        const char* nA = has_next ? (const char*)g.A + (size_t)nxt.pm * tstep : cA; const char* nB = has_next ? (const char*)g.Bt + (size_t)nxt.pn * tstep : cB;
        for (int t = 0; t < nt; t += 2) {
            const bool last = (t == nt - 2);
            const char* a1 = cA + (size_t)(t + 1) * kstep;
            const char* a2 = last ? nA : cA + (size_t)(t + 2) * kstep; const char* b2 = last ? nB : cB + (size_t)(t + 2) * kstep;
            const char* a3 = a2 + kstep; const char* b3 = b2 + kstep;
            if (last && has_next) S.a_ready(nxt);
            if constexpr (Epi::MID_T >= 0) { if (t == Epi::MID_T) E.mid(acc, cur, wr, fr); }
            if constexpr (SP2) {
            PG8_LDB(B0, 0, 0); PG8_LDB(B1, 0, 1); PG8_SCHED; PG8_LDA(At, 0, 0); PG8_STAGE(PG8_SA(1, 1), a1 + hstep, voffA);
            PG8_WAIT_V(8); PG8_WAIT_L(0); PG8_BAR; PG8_MMA(0, 0, At, B0); PG8_MMA(0, 1, At, B1); PG8_BAR; PG8_SCHED;
            PG8_LDA(At, 0, 1); PG8_STAGE(PG8_SB(0, 0), b2, voffB); PG8_STAGE(PG8_SB(0, 1), b2 + hstep, voffB); PG8_STAGE(PG8_SA(0, 0), a2, voffA);
            PG8_WAIT_V(8); PG8_WAIT_L(0); PG8_BAR; PG8_MMA(1, 0, At, B0); PG8_MMA(1, 1, At, B1); PG8_BAR; PG8_SCHED;
            PG8_LDB(B0, 1, 0); PG8_LDB(B1, 1, 1); PG8_SCHED; PG8_LDA(At, 1, 0); PG8_STAGE(PG8_SA(0, 1), a2 + hstep, voffA);
            PG8_WAIT_V(8); PG8_WAIT_L(0); PG8_BAR; PG8_MMA(0, 0, At, B0); PG8_MMA(0, 1, At, B1); PG8_BAR; PG8_SCHED;
            PG8_LDA(At, 1, 1); PG8_STAGE(PG8_SB(1, 0), b3, voffB); PG8_STAGE(PG8_SB(1, 1), b3 + hstep, voffB); PG8_STAGE(PG8_SA(1, 0), a3, voffA);
            PG8_WAIT_V(8); PG8_WAIT_L(0); PG8_BAR; PG8_MMA(1, 0, At, B0); PG8_MMA(1, 1, At, B1); PG8_BAR; PG8_SCHED;
            } else {
            PG8_LDB(B0, 0, 0); PG8_SCHED; PG8_LDA(At, 0, 0); PG8_STAGE(PG8_SA(1, 1), a1 + hstep, voffA);
            PG8_WAIT_L(8); PG8_BAR; PG8_WAIT_L(0); PG8_MMA(0, 0, At, B0); PG8_BAR; PG8_SCHED;
            PG8_LDB(B1, 0, 1); PG8_STAGE(PG8_SB(0, 0), b2, voffB);
            PG8_BAR; PG8_WAIT_L(0); PG8_MMA(0, 1, At, B1); PG8_BAR;
            PG8_LDA(At, 0, 1); PG8_STAGE(PG8_SA(0, 0), a2, voffA);
            PG8_BAR; PG8_WAIT_L(0); PG8_MMA(1, 0, At, B0); PG8_BAR; PG8_SCHED;
            PG8_STAGE(PG8_SB(0, 1), b2 + hstep, voffB);
            PG8_WAIT_V(6); PG8_BAR; PG8_MMA(1, 1, At, B1); PG8_BAR;
            PG8_LDB(B0, 1, 0); PG8_SCHED; PG8_LDA(At, 1, 0); PG8_STAGE(PG8_SA(0, 1), a2 + hstep, voffA);
            PG8_WAIT_L(8); PG8_BAR; PG8_WAIT_L(0); PG8_MMA(0, 0, At, B0); PG8_BAR; PG8_SCHED;
            PG8_LDB(B1, 1, 1); PG8_STAGE(PG8_SB(1, 0), b3, voffB);
            PG8_BAR; PG8_WAIT_L(0); PG8_MMA(0, 1, At, B1); PG8_BAR;
            PG8_LDA(At, 1, 1); PG8_STAGE(PG8_SA(1, 0), a3, voffA);
            PG8_BAR; PG8_WAIT_L(0); PG8_MMA(1, 0, At, B0); PG8_BAR; PG8_SCHED;
            PG8_STAGE(PG8_SB(1, 1), b3 + hstep, voffB);
            PG8_WAIT_V(6); PG8_BAR; PG8_MMA(1, 1, At, B1); PG8_BAR;
            }
        }
        if constexpr (ALIGN_EPI) { if (wr == 0) PG8_BAR; }
        if constexpr (!Epi::AFTER_DRAIN) { E(acc, cur, wr, wc, fr, fq); S.done(cur); }
        if (!has_next) break;
#pragma unroll
        for (int a = 0; a < 2; ++a)
#pragma unroll
            for (int b = 0; b < 2; ++b)
#pragma unroll
                for (int m = 0; m < 4; ++m)
#pragma unroll
                    for (int n = 0; n < 2; ++n) acc[a][b][m][n] = (f32x4){0.f, 0.f, 0.f, 0.f};
        cur = nxt; cA = nA; cB = nB; ++ui;
        if constexpr (ALIGN_EPI) { if (wr == 1) PG8_BAR; }
    }
    PG8_WAIT_V(0);
    if constexpr (!ALIGN_EPI) { if (wr == 0) PG8_BAR; }
    PG8_BAR;
    if constexpr (Epi::AFTER_DRAIN) { E.fused(acc, cur, wr, wc, fr, fq, lds, wid, lane); S.done(cur); }
#undef PG8_SA
#undef PG8_SB
#undef PG8_STAGE
#undef PG8_LDA
#undef PG8_LDB
#undef PG8_MMA
#undef PG8_WAIT_V
#undef PG8_WAIT_L
#undef PG8_BAR
#undef PG8_SCHED
}
}
constexpr int NWAVES = 8, NTHR = 512;
constexpr int MTOK = 16384, DMOD = 1024, NPJ = 3072, NPROJ = 3088, DFF = 2816, NUP = 5632;
constexpr float EPS = 1e-6f;
constexpr size_t MiB = 1u << 20;
constexpr size_t WS_CTL = 0, CTL_ZERO_BYTES = 1 * MiB;
constexpr size_t WS_DT = 1 * MiB;
constexpr size_t WS_WIN = 2 * MiB, WS_WOUT = 8 * MiB, WS_WUP = 10 * MiB, WS_WDN = 21 * MiB;
constexpr size_t WS_AX = 32 * MiB;
constexpr size_t WS_PROJ = 64 * MiB;
constexpr size_t WS_A3 = 160 * MiB;
constexpr size_t WS_YF = 192 * MiB;
constexpr size_t WS_G = 64 * MiB;
constexpr size_t WS_U = 160 * MiB;
constexpr size_t WS_END = 256 * MiB;
static_assert(WS_WDN + (size_t)1024 * 2816 * 2 <= WS_AX && WS_G + (size_t)16384 * 2816 * 2 <= WS_U && WS_U + (size_t)8192 * 5632 * 2 <= WS_END, "ws map");
constexpr int CW_TMO = 0, CW_BAR = 4096, CW_MOD = 16384, CW_SSQY = 73728, CW_SSQ2 = 90112, CW_SSQ3 = 106496, CW_SV2 = 122880;
static_assert(CW_SV2 + 9 * 5632 <= (int)(CTL_ZERO_BYTES / 4), "ctl");
constexpr int LDS_SCRATCH = 153600, LDSCTL_OFF = LDS_SCRATCH, LDS_BYTES = 155648;

#define GAS __attribute__((address_space(1)))
#define LAS __attribute__((address_space(3)))
typedef unsigned short bf16;
typedef unsigned v4u __attribute__((ext_vector_type(4)));
typedef unsigned v2u __attribute__((ext_vector_type(2)));
typedef float f32x4 __attribute__((ext_vector_type(4)));
typedef float f32x16 __attribute__((ext_vector_type(16)));
typedef short bf16x8 __attribute__((ext_vector_type(8)));
typedef short s16x4 __attribute__((ext_vector_type(4)));
typedef float f32x2_t __attribute__((ext_vector_type(2)));
typedef __bf16 bf16x2_t __attribute__((ext_vector_type(2)));
#define LDS_WAIT() asm volatile("s_waitcnt lgkmcnt(0)" ::: "memory")
#define VM_WAIT() asm volatile("s_waitcnt vmcnt(0)" ::: "memory")
__device__ __forceinline__ unsigned pk2(float lo, float hi) { f32x2_t v = {lo, hi}; bf16x2_t b = __builtin_convertvector(v, bf16x2_t); return __builtin_bit_cast(unsigned, b); }
__device__ __forceinline__ float bflo(unsigned u) { return __uint_as_float(u << 16); }
__device__ __forceinline__ float bfhi(unsigned u) { return __uint_as_float(u & 0xffff0000u); }
__device__ __forceinline__ float silu_f(float x) { return x * __builtin_amdgcn_rcpf(1.f + __expf(-x)); }
__device__ __forceinline__ float softplus_f(float x) { return fmaxf(x, 0.f) + log1pf(__expf(-fabsf(x))); }
__device__ __forceinline__ float wave_sum(float v) {
#pragma unroll
    for (int o = 1; o < 64; o <<= 1) v += __shfl_xor(v, o);
    return v;
}

#define XB_TMO      128
#define XB_XCNT(j)  (256  + 64 * (j))
#define XB_XSUB(j)  (1280 + 64 * (j))
#define XB_XGEN(j)  (2304 + 64 * (j))
#define XB_TOP      3328
#define XB_TOPGEN   3392
#define XCD_BAR_WORDS 3456
#define XB_SPIN_CAP (1u << 18)
__device__ __forceinline__ unsigned xb_ld(unsigned* p)              { return __hip_atomic_load(p, __ATOMIC_RELAXED, __HIP_MEMORY_SCOPE_AGENT); }
__device__ __forceinline__ unsigned xb_add(unsigned* p, unsigned v) { return __hip_atomic_fetch_add(p, v, __ATOMIC_RELAXED, __HIP_MEMORY_SCOPE_AGENT); }
__device__ __forceinline__ unsigned xb_xcc_id() { return (unsigned)__builtin_amdgcn_s_getreg((3 << 11) | 20) & 0xFu; }
#define XB_SPIN(cond, bar) do { unsigned _sp = 0; while (cond) { __builtin_amdgcn_s_sleep(1); \
    if ((++_sp & 255u) == 0u) { if (xb_ld(&(bar)[XB_TMO])) break; if (_sp > XB_SPIN_CAP) { atomicAdd(&(bar)[XB_TMO], 1u); break; } } } } while (0)
struct XcdBarrier { unsigned* bar; unsigned x; volatile LAS unsigned* st; };
__device__ __forceinline__ XcdBarrier xcd_barrier_post(unsigned* bar, volatile LAS unsigned* st) {
    XcdBarrier b; b.bar = bar; b.x = xb_xcc_id(); b.st = st;
    if (threadIdx.x == 0) (void)xb_add(&bar[XB_XCNT(b.x)], 1u);
    return b;
}
__device__ __forceinline__ void xcd_barrier_complete(unsigned* bar, unsigned x, unsigned& nloc, unsigned& nx) {
    const unsigned G = gridDim.x * gridDim.y * gridDim.z;
    unsigned sum, cnt, mine, sp = 0u;
    for (;;) {
        sum = 0u; cnt = 0u; mine = 0u;
#pragma unroll
        for (unsigned j = 0; j < 16; ++j) { const unsigned c = xb_ld(&bar[XB_XCNT(j)]); sum += c; cnt += (c > 0u) ? 1u : 0u; mine = (j == x) ? c : mine; }
        if (sum == G) break;
        __builtin_amdgcn_s_sleep(1);
        if ((++sp & 255u) == 0u) { if (xb_ld(&bar[XB_TMO])) break; if (sp > XB_SPIN_CAP) { atomicAdd(&bar[XB_TMO], 1u); break; } }
    }
    nloc = mine > 0u ? mine : 1u; nx = cnt > 0u ? cnt : 1u;
}
__device__ __forceinline__ void xcd_barrier(const XcdBarrier& b) {
    asm volatile("s_waitcnt vmcnt(0)" ::: "memory");
    __syncthreads();
    if (threadIdx.x == 0) {
        unsigned* bar = b.bar;
        __builtin_amdgcn_s_waitcnt(0);
        unsigned nloc = b.st[0], nx = b.st[1];
        if (nloc == 0u) { xcd_barrier_complete(bar, b.x, nloc, nx); b.st[0] = nloc; b.st[1] = nx; }
        const unsigned old = xb_add(&bar[XB_XSUB(b.x)], 1u);
        const unsigned gen = old / nloc;
        if (old + 1u == (gen + 1u) * nloc) {
            __builtin_amdgcn_fence(__ATOMIC_RELEASE, "agent");
            asm volatile("s_waitcnt vmcnt(0)" ::: "memory");
            const unsigned og = xb_add(&bar[XB_TOP], 1u);
            const unsigned tg = og / nx;
            if (og + 1u == (tg + 1u) * nx) xb_add(&bar[XB_TOPGEN], 1u);
            else XB_SPIN(xb_ld(&bar[XB_TOPGEN]) == tg, bar);
            __builtin_amdgcn_fence(__ATOMIC_ACQUIRE, "agent");
            xb_add(&bar[XB_XGEN(b.x)], 1u);
            asm volatile("s_waitcnt vmcnt(0)" ::: "memory");
        } else {
            XB_SPIN(xb_ld(&bar[XB_XGEN(b.x)]) == gen, bar);
            __builtin_amdgcn_fence(__ATOMIC_ACQUIRE, "agent");
            asm volatile("s_waitcnt vmcnt(0)" ::: "memory");
        }
    }
    __syncthreads();
}

struct Args { const float* in[24]; float* out; unsigned char* ws; };
__device__ __forceinline__ int opaque_i(int x) { asm volatile("" : "+v"(x)); return x; }

__device__ __forceinline__ void transpose_item(const float* W, int ldw, int ks0, int n0, bf16* WT, int K, int kd0, LAS float* scr, int lane) {
#pragma unroll 8
    for (int i = 0; i < 32; ++i) { const int kk = 2 * i + (lane >> 5); scr[kk * 33 + (lane & 31)] = W[(size_t)(ks0 + kk) * ldw + n0 + (lane & 31)]; }
    LDS_WAIT(); asm volatile("" ::: "memory");
    const int c = lane & 7;
#pragma unroll
    for (int j = 0; j < 4; ++j) { const int n = (lane >> 3) + 8 * j; const LAS float* s = scr + (8 * c) * 33 + n;
        v4u o; o.x = pk2(s[0 * 33], s[1 * 33]); o.y = pk2(s[2 * 33], s[3 * 33]); o.z = pk2(s[4 * 33], s[5 * 33]); o.w = pk2(s[6 * 33], s[7 * 33]);
        *(GAS v4u*)(WT + (size_t)(n0 + n) * K + kd0 + 8 * c) = o; }
    LDS_WAIT(); asm volatile("" ::: "memory");
}

__device__ __forceinline__ void phase0(const Args& a, LAS unsigned char* lds, int tid, int lane, int wave, int vcu, int G) {
    const float *c = a.in[4], *c_ctx = a.in[5], *w_ada = a.in[8];
    float* modz = (float*)(a.ws + WS_CTL) + CW_MOD;
    LAS float* sc = (LAS float*)lds;
    for (int i = tid; i < 9 * 1024; i += NTHR) { const int mb = i >> 10, k = i & 1023; const float v = mb == 0 ? c_ctx[k] : c[(mb - 1) * 1024 + k]; sc[i] = silu_f(v); }
    __syncthreads();
    for (int it = blockIdx.x; it < 192; it += G) {
        const int cb = it % 12, kc = it / 12, col = cb * 512 + tid;
        float acc[9];
#pragma unroll
        for (int mb = 0; mb < 9; ++mb) acc[mb] = 0.f;
#pragma unroll 8
        for (int kk = 0; kk < 64; ++kk) { const int k = kc * 64 + kk; const float w = w_ada[(size_t)k * 6144 + col];
#pragma unroll
            for (int mb = 0; mb < 9; ++mb) acc[mb] += sc[mb * 1024 + k] * w; }
#pragma unroll
        for (int mb = 0; mb < 9; ++mb) atomicAdd(modz + mb * 6144 + col, acc[mb]);
    }
    LAS float* scr = (LAS float*)(lds + 40960 + wave * 8448);
    const int gw = vcu * NWAVES + wave, NGW = G * NWAVES;
    constexpr int I_IN = 16 * 96, I_OUT = 16 * 32, I_UP = 16 * 176, I_DN = 44 * 32, NITEMS = I_IN + I_OUT + I_UP + I_DN;
    bf16 *WinT = (bf16*)(a.ws + WS_WIN), *WoutT = (bf16*)(a.ws + WS_WOUT), *WupT = (bf16*)(a.ws + WS_WUP), *WdnT = (bf16*)(a.ws + WS_WDN);
    for (int it = gw; it < NITEMS; it += NGW) {
        int r = it;
        if (r < I_IN) { const int kb = r / 96, nb = r % 96; transpose_item(a.in[10], NPROJ, kb * 64, nb * 32, WinT, 1024, kb * 64, scr, lane); continue; } r -= I_IN;
        if (r < I_OUT) { const int kb = r / 32, nb = r % 32; transpose_item(a.in[18], 1024, (kb * 64 + 512) & 1023, nb * 32, WoutT, 1024, kb * 64, scr, lane); continue; } r -= I_OUT;
        if (r < I_UP) { const int kb = r / 176, nb = r % 176; transpose_item(a.in[19], NUP, kb * 64, nb * 32, WupT, 1024, kb * 64, scr, lane); continue; } r -= I_UP;
        { const int kb = r / 32, nb = r % 32; transpose_item(a.in[22], 1024, kb * 64, nb * 32, WdnT, DFF, kb * 64, scr, lane); }
    }
}

__device__ __forceinline__ void phase1(const Args& a, LAS unsigned char* lds, int tid, int lane, int wave, int vcu, int G) {
    const float* modz = (const float*)(a.ws + WS_CTL) + CW_MOD; const float* b_ada = a.in[9];
    float* sv2 = (float*)(a.ws + WS_CTL) + CW_SV2;
    {
        LAS float* shf = (LAS float*)(lds + 65536);
        const float* w_up = a.in[19];
        for (int it = blockIdx.x; it < 176; it += G) {
            const int cb = it % 11, kc = it / 11, col = cb * 512 + tid;
            __syncthreads();
            for (int i = tid; i < 9 * 64; i += NTHR) { const int mb = i >> 6, kk = i & 63; shf[i] = modz[mb * 6144 + 3 * 1024 + kc * 64 + kk] + b_ada[3 * 1024 + kc * 64 + kk]; }
            __syncthreads();
            float acc[9];
#pragma unroll
            for (int mb = 0; mb < 9; ++mb) acc[mb] = 0.f;
#pragma unroll 8
            for (int kk = 0; kk < 64; ++kk) { const float w = w_up[(size_t)(kc * 64 + kk) * NUP + col];
#pragma unroll
                for (int mb = 0; mb < 9; ++mb) acc[mb] += shf[mb * 64 + kk] * w; }
#pragma unroll
            for (int mb = 0; mb < 9; ++mb) atomicAdd(sv2 + mb * 5632 + col, acc[mb]);
        }
    }
    LAS float* wdt = (LAS float*)lds;
    { const float* w_in = a.in[10];
      for (int i = tid; i < 16384; i += NTHR) { const int cc = i >> 4, j = i & 15; wdt[j * 1024 + cc] = w_in[(size_t)cc * NPROJ + NPJ + j]; } }
    __syncthreads();
    const float* g1 = a.in[6]; const float* dt_bias = a.in[14];
    bf16* A1 = (bf16*)(a.ws + WS_AX); float* DT = (float*)(a.ws + WS_DT);
    const int gw = vcu * NWAVES + wave, NGW = G * NWAVES;
    for (int rb = gw; rb < MTOK / 8; rb += NGW) {
        const int row0 = rb * 8, mb = pg8::mb_of_tile(row0 >> 8);
        f32x4 gs[4], sh[4];
#pragma unroll
        for (int jj = 0; jj < 4; ++jj) { const int cc = 4 * lane + 256 * jj;
            gs[jj] = *(const f32x4*)(g1 + cc) * (*(const f32x4*)(modz + mb * 6144 + 1024 + cc) + *(const f32x4*)(b_ada + 1024 + cc) + 1.0f);
            sh[jj] = *(const f32x4*)(modz + mb * 6144 + cc) + *(const f32x4*)(b_ada + cc); }
        for (int rr = 0; rr < 8; ++rr) {
            const int row = row0 + rr;
            asm volatile("" ::: "memory");
            const float* xr = row < 8192 ? a.in[0] + (size_t)row * 1024 : a.in[1] + (size_t)(row - 8192) * 1024;
            f32x4 v[4]; float s = 0.f;
#pragma unroll
            for (int jj = 0; jj < 4; ++jj) { v[jj] = *(const f32x4*)(xr + 4 * lane + 256 * jj); s += (v[jj][0] * v[jj][0] + v[jj][1] * v[jj][1]) + (v[jj][2] * v[jj][2] + v[jj][3] * v[jj][3]); }
            const float r = __builtin_amdgcn_rsqf(wave_sum(s) * (1.0f / 1024.0f) + EPS);
#pragma unroll
            for (int jj = 0; jj < 4; ++jj) { v[jj] = (v[jj] * r) * gs[jj] + sh[jj];
                v2u o; o.x = pk2(v[jj][0], v[jj][1]); o.y = pk2(v[jj][2], v[jj][3]);
                *(GAS v2u*)(A1 + (size_t)row * 1024 + 4 * lane + 256 * jj) = o; }
            float mydt = 0.f;
#pragma unroll
            for (int j = 0; j < 16; ++j) { float p = 0.f;
#pragma unroll
                for (int jj = 0; jj < 4; ++jj) { const f32x4 w = *(const LAS f32x4*)(wdt + j * 1024 + 4 * lane + 256 * jj); p += (v[jj][0] * w[0] + v[jj][1] * w[1]) + (v[jj][2] * w[2] + v[jj][3] * w[3]); }
                p = wave_sum(p); if (lane == j) mydt = p; }
            if (lane < 16) DT[(size_t)row * 16 + lane] = softplus_f(mydt + dt_bias[lane]);
        }
    }
}

constexpr int PK = 272;
constexpr int O_BM = 0, O_BWT = 34816, O_CM = 69632, O_XT = 104448, O_SB = 121856, O_CS = 139264, O_DTV = 139776;
#define MFMA32(a, b, c) __builtin_amdgcn_mfma_f32_32x32x16_bf16((a), (b), (c), 0, 0, 0)

__device__ __forceinline__ void conv8(const bf16* pseq, int t, int L, int pc, const float (&w)[3][8], const float (&b)[8], float (&o)[8]) {
    const v4u z4 = {0u, 0u, 0u, 0u};
    const v4u r0 = t > 0 ? *(const GAS v4u*)(pseq + (size_t)(t - 1) * NPJ + pc) : z4;
    const v4u r1 = *(const GAS v4u*)(pseq + (size_t)t * NPJ + pc);
    const v4u r2 = t < L - 1 ? *(const GAS v4u*)(pseq + (size_t)(t + 1) * NPJ + pc) : z4;
#pragma unroll
    for (int e2 = 0; e2 < 4; ++e2) {
        const float lo = b[2 * e2] + w[0][2 * e2] * bflo(r0[e2]) + w[1][2 * e2] * bflo(r1[e2]) + w[2][2 * e2] * bflo(r2[e2]);
        const float hi = b[2 * e2 + 1] + w[0][2 * e2 + 1] * bfhi(r0[e2]) + w[1][2 * e2 + 1] * bfhi(r1[e2]) + w[2][2 * e2 + 1] * bfhi(r2[e2]);
        o[2 * e2] = silu_f(lo); o[2 * e2 + 1] = silu_f(hi); }
}
__device__ __forceinline__ void load_cw(const float* w, const float* b, int ch0, float (&wo)[3][8], float (&bo)[8]) {
#pragma unroll
    for (int k = 0; k < 3; ++k)
#pragma unroll
        for (int e = 0; e < 8; ++e) wo[k][e] = w[k * 1024 + ch0 + e];
#pragma unroll
    for (int e = 0; e < 8; ++e) bo[e] = b[ch0 + e];
}

__device__ __forceinline__ void ssd_unit(const Args& a, LAS unsigned char* lds, int tid, int lane, int wave, int seq, int h) {
    const bool samp = seq >= 32;
    const int L = samp ? 1024 : 256, nc = L >> 7, row_base = samp ? 8192 + (seq - 32) * 1024 : seq * 256, g = h >> 2;
    const bf16* PROJ = (const bf16*)(a.ws + WS_PROJ); const bf16* pseq = PROJ + (size_t)row_base * NPJ;
    const float* DT = (const float*)(a.ws + WS_DT);
    bf16* A3 = (bf16*)(a.ws + WS_A3);
    float* YF = (float*)(a.ws + WS_YF) + (size_t)row_base * 512 + (size_t)h * 64 * L;
    float* ssqy = (float*)(a.ws + WS_CTL) + CW_SSQY;
    const float *w_cs = a.in[11], *w_cssd = a.in[12], *b_cssd = a.in[13], *a_log = a.in[15], *g_ssd = a.in[17];
    const float dskip = a.in[16][h];
    LAS float* CS = (LAS float*)(lds + O_CS); LAS float* DTV = (LAS float*)(lds + O_DTV);
    const int hh = lane >> 5, l31 = lane & 31;
    const int jt = wave >> 1, q = wave & 1;
    const int el = tid >> 2, eq = tid & 3;

    for (int dir = 0; dir < 2; ++dir) {
        const float aA = -__expf(a_log[dir * 8 + h]);
        f32x16 St;
        if (samp) { const float* init = a.in[2 + dir] + ((size_t)((seq - 32) * 8 + h) * 64 + 32 * q + l31) * 128 + 32 * jt;
#pragma unroll
            for (int gq = 0; gq < 4; ++gq) { const f32x4 v = *(const f32x4*)(init + 8 * gq + 4 * hh); St[4 * gq] = v[0]; St[4 * gq + 1] = v[1]; St[4 * gq + 2] = v[2]; St[4 * gq + 3] = v[3]; }
        } else {
#pragma unroll
            for (int i = 0; i < 16; ++i) St[i] = 0.f;
        }
        __syncthreads();
#pragma unroll
        for (int gq = 0; gq < 4; ++gq) { v2u o; o.x = pk2(St[4 * gq], St[4 * gq + 1]); o.y = pk2(St[4 * gq + 2], St[4 * gq + 3]);
            *(LAS v2u*)(lds + O_SB + (32 * q + l31) * PK + (32 * jt + 8 * gq + 4 * hh) * 2) = o; }

        for (int k = 0; k < nc; ++k) {
            if (wave == 0) {
                const int j0 = k * 128 + 2 * lane, t0 = dir ? L - 1 - j0 : j0, t1 = dir ? t0 - 1 : t0 + 1;
                const float d0 = DT[(size_t)(row_base + t0) * 16 + dir * 8 + h], d1 = DT[(size_t)(row_base + t1) * 16 + dir * 8 + h];
                const float a0 = d0 * aA, a1 = d1 * aA, s = a0 + a1;
                float incl = s;
#pragma unroll
                for (int o = 1; o < 64; o <<= 1) { const float v = __shfl_up(incl, o); if (lane >= o) incl += v; }
                const float excl = incl - s;
                CS[2 * lane] = excl + a0; CS[2 * lane + 1] = excl + s; DTV[2 * lane] = d0; DTV[2 * lane + 1] = d1;
            }
            float bkeep[4][8];
            {   float w[3][8], b[8], o[8];
                { const int cg = tid & 7; load_cw(w_cssd, b_cssd, h * 64 + cg * 8, w, b);
#pragma unroll
                  for (int jj = 0; jj < 2; ++jj) { const int i = (tid + 512 * jj) >> 3, j = k * 128 + i, t = dir ? L - 1 - j : j;
                      conv8(pseq, t, L, 2048 + h * 64 + cg * 8, w, b, o);
#pragma unroll
                      for (int e = 0; e < 8; ++e) *(LAS bf16*)(lds + O_XT + (cg * 8 + e) * PK + i * 2) = (bf16)(pk2(o[e], 0.f) & 0xffffu); } }
                { const int cg = tid & 15; load_cw(w_cssd, b_cssd, 768 + g * 128 + cg * 8, w, b);
#pragma unroll
                  for (int jj = 0; jj < 4; ++jj) { const int i = (tid + 512 * jj) >> 4, j = k * 128 + i, t = dir ? L - 1 - j : j;
                      conv8(pseq, t, L, 2048 + 768 + g * 128 + cg * 8, w, b, o);
                      v4u pk; pk.x = pk2(o[0], o[1]); pk.y = pk2(o[2], o[3]); pk.z = pk2(o[4], o[5]); pk.w = pk2(o[6], o[7]);
                      *(LAS v4u*)(lds + O_CM + i * PK + cg * 16) = pk; } }
                { const int cg = tid & 15; load_cw(w_cssd, b_cssd, 512 + g * 128 + cg * 8, w, b);
#pragma unroll
                  for (int jj = 0; jj < 4; ++jj) { const int i = (tid + 512 * jj) >> 4, j = k * 128 + i, t = dir ? L - 1 - j : j;
                      conv8(pseq, t, L, 2048 + 512 + g * 128 + cg * 8, w, b, o);
                      v4u pk; pk.x = pk2(o[0], o[1]); pk.y = pk2(o[2], o[3]); pk.z = pk2(o[4], o[5]); pk.w = pk2(o[6], o[7]);
                      *(LAS v4u*)(lds + O_BM + i * PK + cg * 16) = pk;
#pragma unroll
                      for (int e = 0; e < 8; ++e) bkeep[jj][e] = o[e]; } }
            }
            __syncthreads();
            { const int cg = tid & 15; const float cend = CS[127];
#pragma unroll
              for (int jj = 0; jj < 4; ++jj) { const int i = (tid + 512 * jj) >> 4; const float wg = DTV[i] * __expf(cend - CS[i]);
#pragma unroll
                  for (int e = 0; e < 8; ++e) *(LAS bf16*)(lds + O_BWT + (cg * 8 + e) * PK + i * 2) = (bf16)(pk2(bkeep[jj][e] * wg, 0.f) & 0xffffu); } }
            __syncthreads();

            bf16x8 cf[8];
#pragma unroll
            for (int ks = 0; ks < 8; ++ks) cf[ks] = *(const LAS bf16x8*)(lds + O_CM + (32 * jt + l31) * PK + (16 * ks + 8 * hh) * 2);
            f32x16 Y;
#pragma unroll
            for (int i = 0; i < 16; ++i) Y[i] = 0.f;
#pragma unroll
            for (int ks = 0; ks < 8; ++ks) { const bf16x8 sa = *(const LAS bf16x8*)(lds + O_SB + (32 * q + l31) * PK + (16 * ks + 8 * hh) * 2); Y = MFMA32(sa, cf[ks], Y); }
            const float csl = CS[32 * jt + l31];
            { const float el_ = __expf(csl);
#pragma unroll
              for (int i = 0; i < 16; ++i) Y[i] *= el_; }
            for (int it = 0; it <= jt; ++it) {
                f32x16 Gt;
#pragma unroll
                for (int i = 0; i < 16; ++i) Gt[i] = 0.f;
#pragma unroll
                for (int ks = 0; ks < 8; ++ks) { const bf16x8 ba = *(const LAS bf16x8*)(lds + O_BM + (32 * it + l31) * PK + (16 * ks + 8 * hh) * 2); Gt = MFMA32(ba, cf[ks], Gt); }
                const bool dg = (it == jt);
#pragma unroll
                for (int gq = 0; gq < 4; ++gq) {
                    const f32x4 cs4 = *(const LAS f32x4*)(CS + 32 * it + 8 * gq + 4 * hh), dt4 = *(const LAS f32x4*)(DTV + 32 * it + 8 * gq + 4 * hh);
#pragma unroll
                    for (int e = 0; e < 4; ++e) { const int sl = 8 * gq + 4 * hh + e;
                        float v = Gt[4 * gq + e] * dt4[e] * __expf(csl - cs4[e]);
                        if (dg) { if (sl > l31) v = 0.f; if (dir == 0 && sl == l31) v += dskip; }
                        Gt[4 * gq + e] = v; }
                }
#pragma unroll
                for (int st = 0; st < 2; ++st) {
                    v4u pb; pb.x = pk2(Gt[8 * st], Gt[8 * st + 1]); pb.y = pk2(Gt[8 * st + 2], Gt[8 * st + 3]); pb.z = pk2(Gt[8 * st + 4], Gt[8 * st + 5]); pb.w = pk2(Gt[8 * st + 6], Gt[8 * st + 7]);
                    const s16x4 xa0 = *(const LAS s16x4*)(lds + O_XT + (32 * q + l31) * PK + (32 * it + 16 * st + 4 * hh) * 2);
                    const s16x4 xa1 = *(const LAS s16x4*)(lds + O_XT + (32 * q + l31) * PK + (32 * it + 16 * st + 8 + 4 * hh) * 2);
                    const bf16x8 xa = __builtin_shufflevector(xa0, xa1, 0, 1, 2, 3, 4, 5, 6, 7);
                    Y = MFMA32(xa, __builtin_bit_cast(bf16x8, pb), Y);
                }
            }
            { const float cd = __expf(CS[127]);
#pragma unroll
              for (int i = 0; i < 16; ++i) St[i] *= cd; }
#pragma unroll
            for (int ks = 0; ks < 8; ++ks) {
                const bf16x8 wa = *(const LAS bf16x8*)(lds + O_BWT + (32 * jt + l31) * PK + (16 * ks + 8 * hh) * 2);
                const bf16x8 xb = *(const LAS bf16x8*)(lds + O_XT + (32 * q + l31) * PK + (16 * ks + 8 * hh) * 2);
                St = MFMA32(wa, xb, St);
            }
            __syncthreads();
#pragma unroll
            for (int gq = 0; gq < 4; ++gq) { v2u o; o.x = pk2(St[4 * gq], St[4 * gq + 1]); o.y = pk2(St[4 * gq + 2], St[4 * gq + 3]);
                *(LAS v2u*)(lds + O_SB + (32 * q + l31) * PK + (32 * jt + 8 * gq + 4 * hh) * 2) = o; }
            if (!samp && k == nc - 1) {
                float* so = a.out + (size_t)2 * 8192 * 1024 + (size_t)dir * 2097152 + ((size_t)(seq * 8 + h) * 64 + 32 * q + l31) * 128 + 32 * jt;
#pragma unroll
                for (int gq = 0; gq < 4; ++gq) { f32x4 v = {St[4 * gq], St[4 * gq + 1], St[4 * gq + 2], St[4 * gq + 3]}; *(f32x4*)(so + 8 * gq + 4 * hh) = v; }
            }
            const int jl = k * 128 + 32 * jt + l31, tl = dir ? L - 1 - jl : jl;
            if (dir == 0) {
#pragma unroll
                for (int i = 0; i < 16; ++i) { const int p = 32 * q + (i & 3) + 8 * (i >> 2) + 4 * hh; YF[(size_t)p * L + tl] = Y[i]; }
                { const int t = k * 128 + el; const bf16* pr = pseq + (size_t)t * NPJ; const int c0 = h * 64 + 16 * eq;
                  float acc[16];
#pragma unroll
                  for (int e = 0; e < 16; ++e) acc[e] = 0.f;
#pragma unroll
                  for (int kk = 0; kk < 3; ++kk) { const int tt = t + kk - 1;
                      if (tt >= 0 && tt < L) { const bf16* p2 = pr + (ptrdiff_t)(kk - 1) * NPJ;
#pragma unroll
                          for (int hv = 0; hv < 2; ++hv) { const v4u hc = *(const GAS v4u*)(p2 + c0 + 8 * hv), gc = *(const GAS v4u*)(p2 + 1024 + c0 + 8 * hv);
#pragma unroll
                              for (int e2 = 0; e2 < 4; ++e2) { acc[8 * hv + 2 * e2] += w_cs[kk * 512 + c0 + 8 * hv + 2 * e2] * (bflo(hc[e2]) * bflo(gc[e2]));
                                  acc[8 * hv + 2 * e2 + 1] += w_cs[kk * 512 + c0 + 8 * hv + 2 * e2 + 1] * (bfhi(hc[e2]) * bfhi(gc[e2])); } } } }
#pragma unroll
                  for (int hv = 0; hv < 2; ++hv) { const v4u gb = *(const GAS v4u*)(pr + 512 + c0 + 8 * hv); v4u o;
#pragma unroll
                      for (int e2 = 0; e2 < 4; ++e2) o[e2] = pk2(acc[8 * hv + 2 * e2] * bflo(gb[e2]), acc[8 * hv + 2 * e2 + 1] * bfhi(gb[e2]));
                      *(GAS v4u*)(A3 + (size_t)(row_base + t) * 1024 + 512 + c0 + 8 * hv) = o; } }
            } else {
#pragma unroll
                for (int i = 0; i < 16; ++i) { const int p = 32 * q + (i & 3) + 8 * (i >> 2) + 4 * hh; Y[i] += YF[(size_t)p * L + tl]; }
                LAS float* YS = (LAS float*)(lds + O_BM);
#pragma unroll
                for (int gq = 0; gq < 4; ++gq) { f32x4 v = {Y[4 * gq], Y[4 * gq + 1], Y[4 * gq + 2], Y[4 * gq + 3]}; *(LAS f32x4*)(YS + (32 * jt + l31) * 68 + 32 * q + 8 * gq + 4 * hh) = v; }
                __syncthreads();
                { const int j = k * 128 + el, t = L - 1 - j; const size_t row = (size_t)row_base + t; const int c0 = h * 64 + 16 * eq;
                  float sq = 0.f;
#pragma unroll
                  for (int hv = 0; hv < 2; ++hv) { const v4u z = *(const GAS v4u*)(PROJ + row * NPJ + 1536 + c0 + 8 * hv); v4u o;
                      const f32x4 y0 = *(const LAS f32x4*)(YS + el * 68 + 16 * eq + 8 * hv), y1 = *(const LAS f32x4*)(YS + el * 68 + 16 * eq + 8 * hv + 4);
                      const f32x4 gg0 = *(const f32x4*)(g_ssd + c0 + 8 * hv), gg1 = *(const f32x4*)(g_ssd + c0 + 8 * hv + 4);
                      float yz[8];
                      yz[0] = y0[0] * silu_f(bflo(z[0])); yz[1] = y0[1] * silu_f(bfhi(z[0])); yz[2] = y0[2] * silu_f(bflo(z[1])); yz[3] = y0[3] * silu_f(bfhi(z[1]));
                      yz[4] = y1[0] * silu_f(bflo(z[2])); yz[5] = y1[1] * silu_f(bfhi(z[2])); yz[6] = y1[2] * silu_f(bflo(z[3])); yz[7] = y1[3] * silu_f(bfhi(z[3]));
#pragma unroll
                      for (int e = 0; e < 8; ++e) sq += yz[e] * yz[e];
                      o.x = pk2(yz[0] * gg0[0], yz[1] * gg0[1]); o.y = pk2(yz[2] * gg0[2], yz[3] * gg0[3]); o.z = pk2(yz[4] * gg1[0], yz[5] * gg1[1]); o.w = pk2(yz[6] * gg1[2], yz[7] * gg1[3]);
                      *(GAS v4u*)(A3 + row * 1024 + c0 + 8 * hv) = o; }
                  sq += __shfl_xor(sq, 1); sq += __shfl_xor(sq, 2);
                  if (eq == 0) atomicAdd(ssqy + row, sq); }
            }
            __syncthreads();
        }
        VM_WAIT();
    }
}

__device__ __forceinline__ void phase3(const Args& a, LAS unsigned char* lds, int tid, int lane, int wave, int vcu, int G) {
    const int nrest = G - 64;
    if (nrest <= 0) { for (int u = vcu; u < 320; u += G) { const int seq = u < 64 ? 32 + (u >> 3) : (u - 64) >> 3, h = u & 7; ssd_unit(a, lds, tid, lane, wave, seq, h); } return; }
    if (vcu < 64) { ssd_unit(a, lds, tid, lane, wave, 32 + (vcu >> 3), vcu & 7); return; }
    for (int qn = vcu - 64; qn < 256; qn += nrest) ssd_unit(a, lds, tid, lane, wave, qn >> 3, qn & 7);
}

template <bool LAT>
__device__ __forceinline__ void conv_ffn(const Args& a, int half, int lane, int gw) {
    constexpr int NT = LAT ? 9 : 3;
    const bf16* U = (const bf16*)(a.ws + WS_U); bf16* Gb = (bf16*)(a.ws + WS_G) + (size_t)half * 8192 * DFF;
    const float* wf = a.in[20]; const float* bfc = a.in[21];
    const int cgb = gw % 11, tg = gw / 11;
    if (tg >= 186) return;
    const int c = (cgb * 64 + lane) * 4;
    float w[NT][2][4], b[2][4];
#pragma unroll
    for (int tp = 0; tp < NT; ++tp)
#pragma unroll
        for (int s = 0; s < 2; ++s) { const f32x4 v = *(const f32x4*)(wf + (size_t)(LAT ? tp : 3 + tp) * NUP + s * DFF + c); w[tp][s][0] = v[0]; w[tp][s][1] = v[1]; w[tp][s][2] = v[2]; w[tp][s][3] = v[3]; }
#pragma unroll
    for (int s = 0; s < 2; ++s) { const f32x4 v = *(const f32x4*)(bfc + s * DFF + c); b[s][0] = v[0]; b[s][1] = v[1]; b[s][2] = v[2]; b[s][3] = v[3]; }
    const int r1 = (tg * 45 + 45) < 8192 ? (tg * 45 + 45) : 8192;
    for (int r = tg * 45; r < r1; ++r) {
        float acc[2][4];
#pragma unroll
        for (int s = 0; s < 2; ++s)
#pragma unroll
            for (int e = 0; e < 4; ++e) acc[s][e] = b[s][e];
        const bf16* ur = U + (size_t)r * NUP + c;
        if (LAT) { const int tl = r & 1023, gr = tl >> 6, gc = tl & 63;
#pragma unroll
            for (int di = 0; di < 3; ++di)
#pragma unroll
                for (int dj = 0; dj < 3; ++dj) { const int rr = gr + di - 1, c2 = gc + dj - 1;
                    if (rr >= 0 && rr < 16 && c2 >= 0 && c2 < 64) { const bf16* up = ur + (ptrdiff_t)((di - 1) * 64 + (dj - 1)) * NUP;
#pragma unroll
                        for (int s = 0; s < 2; ++s) { const v2u v = *(const GAS v2u*)(up + s * DFF);
                            acc[s][0] += w[di * 3 + dj][s][0] * bflo(v.x); acc[s][1] += w[di * 3 + dj][s][1] * bfhi(v.x); acc[s][2] += w[di * 3 + dj][s][2] * bflo(v.y); acc[s][3] += w[di * 3 + dj][s][3] * bfhi(v.y); } } }
        } else { const int tl = r & 255;
#pragma unroll
            for (int dj = 0; dj < 3; ++dj) { const int t2 = tl + dj - 1;
                if (t2 >= 0 && t2 < 256) { const bf16* up = ur + (ptrdiff_t)(dj - 1) * NUP;
#pragma unroll
                    for (int s = 0; s < 2; ++s) { const v2u v = *(const GAS v2u*)(up + s * DFF);
                        acc[s][0] += w[dj][s][0] * bflo(v.x); acc[s][1] += w[dj][s][1] * bfhi(v.x); acc[s][2] += w[dj][s][2] * bflo(v.y); acc[s][3] += w[dj][s][3] * bfhi(v.y); } } }
        }
        v2u o; o.x = pk2(silu_f(acc[0][0]) * acc[1][0], silu_f(acc[0][1]) * acc[1][1]); o.y = pk2(silu_f(acc[0][2]) * acc[1][2], silu_f(acc[0][3]) * acc[1][3]);
        *(GAS v2u*)(Gb + (size_t)r * DFF + c) = o;
    }
}

__device__ __forceinline__ void phase8(const Args& a, int lane, int gw, int NGW) {
    const float* ssq3 = (const float*)(a.ws + WS_CTL) + CW_SSQ3; const float* gf = a.in[23];
    f32x4 g4[4];
#pragma unroll
    for (int jj = 0; jj < 4; ++jj) g4[jj] = *(const f32x4*)(gf + 4 * lane + 256 * jj);
    for (int rb = gw; rb < MTOK / 8; rb += NGW)
        for (int rr = 0; rr < 8; ++rr) { const int row = rb * 8 + rr; float* xr = a.out + (size_t)row * 1024;
            const float r = __builtin_amdgcn_rsqf(ssq3[row] * (1.0f / 1024.0f) + EPS);
#pragma unroll
            for (int jj = 0; jj < 4; ++jj) { const f32x4 v = *(const f32x4*)(xr + 4 * lane + 256 * jj); *(f32x4*)(xr + 4 * lane + 256 * jj) = (v * r) * g4[jj]; } }
}

__global__ void __launch_bounds__(NTHR, 2) mega_fwd(Args a) {
    extern __shared__ __attribute__((aligned(16))) unsigned char lds_raw[];
    LAS unsigned char* lds = (LAS unsigned char*)lds_raw;
#define PH_IDS const int tid = opaque_i((int)threadIdx.x), lane = tid & 63, wave = __builtin_amdgcn_readfirstlane(tid >> 6); const int gw = vcu * NWAVES + wave; (void)gw; (void)lane;
    const int G = gridDim.x; const int bx = blockIdx.x; const int vcu = (G % 8 == 0) ? (bx % 8) * (G / 8) + bx / 8 : bx;
    const int NGW = G * NWAVES;
    unsigned* ctl = (unsigned*)(a.ws + WS_CTL); float* ctlf = (float*)ctl;
    for (int u = threadIdx.x; u < (LDS_BYTES - LDSCTL_OFF) / 4; u += NTHR) ((LAS unsigned*)(lds + LDSCTL_OFF))[u] = 0u;
    __syncthreads();
    XcdBarrier bar = xcd_barrier_post(ctl + CW_BAR, (volatile LAS unsigned*)(lds + LDSCTL_OFF + 64));

#ifndef NO_P0
    { PH_IDS phase0(a, lds, tid, lane, wave, vcu, G); }
#endif
    xcd_barrier(bar);
#ifndef NO_P1
    { PH_IDS phase1(a, lds, tid, lane, wave, vcu, G); }
#endif
    xcd_barrier(bar);
    {
        pg8::Gemm g{(const pg8::bf16_t*)(a.ws + WS_AX), (const pg8::bf16_t*)(a.ws + WS_WIN), MTOK, NPJ, 1024}; pg8::StaticOrder S; S.init(MTOK, NPJ, G, bx);
        pg8::EpiPlainBf16 E{(pg8::bf16_t*)(a.ws + WS_PROJ), NPJ};
#ifndef NO_G2
        pg8::gemm_phase<pg8::EpiPlainBf16, pg8::StaticOrder, true, true>(lds, g, S, E);
#endif
    }
    xcd_barrier(bar);
#ifndef NO_P3
    { PH_IDS phase3(a, lds, tid, lane, wave, vcu, G); }
#endif
    xcd_barrier(bar);
    {
        pg8::Gemm g{(const pg8::bf16_t*)(a.ws + WS_A3), (const pg8::bf16_t*)(a.ws + WS_WOUT), MTOK, 1024, 1024}; pg8::StaticOrder S; S.init(MTOK, 1024, G, bx);
        pg8::EpiOut E{a.in[0], a.in[1], a.out, (pg8::bf16_t*)(a.ws + WS_AX), ctlf + CW_MOD, a.in[9], a.in[7], ctlf + CW_SSQ2, ctlf + CW_SSQY};
#ifndef NO_G4
        pg8::gemm_phase<pg8::EpiOut, pg8::StaticOrder, true, true>(lds, g, S, E);
#endif
    }
    xcd_barrier(bar);
    for (int half = 0; half < 2; ++half) {
        {
            pg8::Gemm g{(const pg8::bf16_t*)(a.ws + WS_AX) + (size_t)half * 8192 * 1024, (const pg8::bf16_t*)(a.ws + WS_WUP), 8192, NUP, 1024}; pg8::StaticOrder S; S.init(8192, NUP, G, bx);
            pg8::EpiUp E{(pg8::bf16_t*)(a.ws + WS_U), ctlf + CW_SSQ2, ctlf + CW_SV2, half * 32};
#ifndef NO_G5
            pg8::gemm_phase<pg8::EpiUp, pg8::StaticOrder, true, true>(lds, g, S, E);
#endif
        }
        xcd_barrier(bar);
#ifndef NO_P6
        { PH_IDS if (half == 0) conv_ffn<false>(a, 0, lane, gw); else conv_ffn<true>(a, 1, lane, gw); }
#endif
        xcd_barrier(bar);
    }
    {
        pg8::Gemm g{(const pg8::bf16_t*)(a.ws + WS_G), (const pg8::bf16_t*)(a.ws + WS_WDN), MTOK, 1024, DFF}; pg8::StaticOrder S; S.init(MTOK, 1024, G, bx);
        pg8::EpiDown E{a.out, ctlf + CW_MOD, a.in[9], ctlf + CW_SSQ3};
#ifndef NO_G7
        pg8::gemm_phase<pg8::EpiDown, pg8::StaticOrder, true, true>(lds, g, S, E);
#endif
    }
    xcd_barrier(bar);
#ifndef NO_P8
    { PH_IDS phase8(a, lane, gw, NGW); }
#endif
}

extern "C" void kernel_launch(void* const* d_in, const int* in_sizes, int n_in, void* d_out, int out_size, void* d_ws, size_t ws_size, hipStream_t stream) {
    static int grid = 0;
    if (grid == 0) {
        if (n_in != 24 || ws_size < WS_END) { fprintf(stderr, "kernel_launch: unexpected problem (n_in %d, ws %zu)\n", n_in, ws_size); grid = -1; return; }
        int dev = 0, cus = 0, per_cu = 0;
        if (hipGetDevice(&dev) != hipSuccess || hipDeviceGetAttribute(&cus, hipDeviceAttributeMultiprocessorCount, dev) != hipSuccess) { grid = -1; return; }
        if (hipFuncSetAttribute((const void*)mega_fwd, hipFuncAttributeMaxDynamicSharedMemorySize, LDS_BYTES) != hipSuccess) { fprintf(stderr, "kernel_launch: hipFuncSetAttribute failed\n"); grid = -1; return; }
        if (hipOccupancyMaxActiveBlocksPerMultiprocessor(&per_cu, (const void*)mega_fwd, NTHR, LDS_BYTES) != hipSuccess || per_cu < 1) { fprintf(stderr, "kernel_launch: occupancy query says %d\n", per_cu); per_cu = 1; }
        (void)hipGetLastError();
        grid = cus;
    }
    if (grid < 0) return;
    (void)hipMemsetAsync((char*)d_ws + WS_CTL, 0, CTL_ZERO_BYTES, stream);
    Args a{};
    for (int i = 0; i < 24; ++i) a.in[i] = (const float*)d_in[i];
    a.out = (float*)d_out; a.ws = (unsigned char*)d_ws;
    hipLaunchKernelGGL(mega_fwd, dim3(grid), dim3(NTHR), LDS_BYTES, stream, a);
}
```

```cpp
#include <hip/hip_runtime.h>
#include <cstdio>
#include <cstdint>
namespace pg8 {
#define PG8_LAS __attribute__((address_space(3)))
typedef unsigned short bf16_t;
typedef short bf16x8 __attribute__((ext_vector_type(8)));
typedef float f32x4 __attribute__((ext_vector_type(4)));
typedef unsigned u32x4 __attribute__((ext_vector_type(4)));
constexpr int BM = 256, BK = 64, HALF = 128, HTB = HALF * BK * 2  , STAGE_BYTES = 8 * HTB, NXCD = 8, WGM = 8;

__host__ __device__ __forceinline__ int lds_byte(int r, int c) { const int st = (r >> 4) * 2 + (c >> 5), rr = r & 15, cc = c & 31, ob = rr * 64 + cc * 2; return st * 1024 + (ob ^ (((ob >> 9) & 1) << 5)); }
__host__ __device__ __forceinline__ void stage_rc(int b, int& R, int& C) { const int st = b / 1024, sb = b % 1024, swz = sb ^ (((sb >> 9) & 1) << 5); R = (st >> 1) * 16 + swz / 64; C = (st & 1) * 32 + (swz % 64) / 2; }
__host__ __device__ __forceinline__ int perm32(int rho) { const int n = rho >> 4, i = rho & 15; return 8 * (i >> 2) + 4 * n + (i & 3); }

struct Unit { int pm, pn; };
struct Gemm { const bf16_t* A; const bf16_t* Bt; int M, N, K; };

struct StaticOrder {
    int nM, nN, nwg, G, c;
    __host__ __device__ void init(int M, int N, int G_, int c_) { nM = M / BM; nN = N / BM; nwg = nM * nN; G = G_; c = c_; }
    __host__ __device__ bool next(int i, Unit& u) const {
        const long L = (long)i * G + c; if (L >= nwg) return false;
        int wgid = (int)L; { const int q = nwg / NXCD, r = nwg % NXCD, xcd = wgid % NXCD, off = wgid / NXCD; wgid = (xcd < r ? xcd * (q + 1) : r * (q + 1) + (xcd - r) * q) + off; }
        const int nig = WGM * nN, gid = wgid / nig, fm = gid * WGM, gsz = (nM - fm) < WGM ? (nM - fm) : WGM;
        u.pm = fm + ((wgid % nig) % gsz); u.pn = (wgid % nig) / gsz; return true;
    }
    __device__ __forceinline__ void a_ready(const Unit&) const {}
    __device__ __forceinline__ void done(const Unit&) const {}
};

__device__ __forceinline__ unsigned cvt_pk_bf16(float lo, float hi) { unsigned r; asm volatile("v_cvt_pk_bf16_f32 %0, %1, %2" : "=v"(r) : "v"(lo), "v"(hi)); return r; }
constexpr float RMS_EPS = 1e-6f;
__device__ __forceinline__ int mb_of_tile(int gpm) { return gpm < 32 ? 0 : 1 + ((gpm - 32) >> 2); }

struct EpiPlainBf16 {
    static constexpr bool PERM = true, AFTER_DRAIN = false; static constexpr int MID_T = -1;
    bf16_t* O; int ldc;
    __device__ __forceinline__ void mid(f32x4 (&)[2][2][4][2], const Unit&, int, int) const {}
    __device__ __forceinline__ void operator()(const f32x4 (&acc)[2][2][4][2], const Unit& u, int wr, int wc, int fr, int fq) const {
        const int row0 = u.pm * BM + wr * 64 + fr, col0 = u.pn * BM + wc * 32 + 8 * fq;
#pragma unroll
        for (int ai = 0; ai < 2; ++ai)
#pragma unroll
            for (int m = 0; m < 4; ++m) { bf16_t* rowp = O + (size_t)(row0 + ai * HALF + m * 16) * ldc + col0;
#pragma unroll
                for (int bj = 0; bj < 2; ++bj) { const f32x4 v0 = acc[ai][bj][m][0], v1 = acc[ai][bj][m][1];
                    u32x4 w; w.x = cvt_pk_bf16(v0[0], v0[1]); w.y = cvt_pk_bf16(v0[2], v0[3]); w.z = cvt_pk_bf16(v1[0], v1[1]); w.w = cvt_pk_bf16(v1[2], v1[3]);
                    *(u32x4*)(rowp + bj * HALF) = w; } }
    }
};

struct EpiUp {
    static constexpr bool PERM = true, AFTER_DRAIN = false; static constexpr int MID_T = -1;
    bf16_t* O; const float* ssq; const float* sv; int tile0;
    __device__ __forceinline__ void mid(f32x4 (&)[2][2][4][2], const Unit&, int, int) const {}
    __device__ __forceinline__ void operator()(const f32x4 (&acc)[2][2][4][2], const Unit& u, int wr, int wc, int fr, int fq) const {
        const int gpm = tile0 + u.pm, mb = mb_of_tile(gpm);
        const int lrow0 = u.pm * BM + wr * 64 + fr, col0 = u.pn * BM + wc * 32 + 8 * fq;
        f32x4 bv[2][2];
#pragma unroll
        for (int bj = 0; bj < 2; ++bj)
#pragma unroll
            for (int n = 0; n < 2; ++n) bv[bj][n] = *(const f32x4*)(sv + (size_t)mb * 5632 + col0 + bj * HALF + 4 * n);
#pragma unroll
        for (int ai = 0; ai < 2; ++ai)
#pragma unroll
            for (int m = 0; m < 4; ++m) { const int lrow = lrow0 + ai * HALF + m * 16;
                const float r = __builtin_amdgcn_rsqf(ssq[(size_t)tile0 * BM + lrow] * (1.0f / 1024.0f) + RMS_EPS);
                bf16_t* rowp = O + (size_t)lrow * 5632 + col0;
#pragma unroll
                for (int bj = 0; bj < 2; ++bj) { const f32x4 v0 = acc[ai][bj][m][0] * r + bv[bj][0], v1 = acc[ai][bj][m][1] * r + bv[bj][1];
                    u32x4 w; w.x = cvt_pk_bf16(v0[0], v0[1]); w.y = cvt_pk_bf16(v0[2], v0[3]); w.z = cvt_pk_bf16(v1[0], v1[1]); w.w = cvt_pk_bf16(v1[2], v1[3]);
                    *(u32x4*)(rowp + bj * HALF) = w; } }
    }
};

struct EpiOut {
    static constexpr bool PERM = false, AFTER_DRAIN = false; static constexpr int MID_T = 8;
    const float* xp; const float* xs; float* x1; bf16_t* A2; const float* modz; const float* b_ada; const float* g2; float* ssq2; const float* ssqy;
    __device__ __forceinline__ void mid(f32x4 (&acc)[2][2][4][2], const Unit& u, int wr, int fr) const {
#pragma unroll
        for (int ai = 0; ai < 2; ++ai)
#pragma unroll
            for (int m = 0; m < 4; ++m) { const int row = u.pm * BM + ai * HALF + wr * 64 + m * 16 + fr;
                const float ry = __builtin_amdgcn_rsqf(ssqy[row] * (1.0f / 512.0f) + RMS_EPS);
#pragma unroll
                for (int bj = 0; bj < 2; ++bj)
#pragma unroll
                    for (int n = 0; n < 2; ++n) acc[ai][bj][m][n] = acc[ai][bj][m][n] * ry; }
    }
    __device__ __forceinline__ void operator()(const f32x4 (&acc)[2][2][4][2], const Unit& u, int wr, int wc, int fr, int fq) const {
        const int mb = mb_of_tile(u.pm), col0 = u.pn * BM + wc * 32 + 4 * fq;
        f32x4 gate[2][2], gs[2][2];
#pragma unroll
        for (int bj = 0; bj < 2; ++bj)
#pragma unroll
            for (int n = 0; n < 2; ++n) { const int c = col0 + bj * HALF + n * 16;
                gate[bj][n] = *(const f32x4*)(modz + mb * 6144 + 2 * 1024 + c) + *(const f32x4*)(b_ada + 2 * 1024 + c);
                gs[bj][n] = *(const f32x4*)(g2 + c) * (*(const f32x4*)(modz + mb * 6144 + 4 * 1024 + c) + *(const f32x4*)(b_ada + 4 * 1024 + c) + 1.0f); }
#pragma unroll
        for (int ai = 0; ai < 2; ++ai)
#pragma unroll
            for (int m = 0; m < 4; ++m) { const int row = u.pm * BM + ai * HALF + wr * 64 + m * 16 + fr;
                const float* xr = row < 8192 ? xp + (size_t)row * 1024 : xs + (size_t)(row - 8192) * 1024;
                float sq = 0.f;
#pragma unroll
                for (int bj = 0; bj < 2; ++bj)
#pragma unroll
                    for (int n = 0; n < 2; ++n) { const int c = col0 + bj * HALF + n * 16;
                        const f32x4 v = *(const f32x4*)(xr + c) + gate[bj][n] * acc[ai][bj][m][n];
                        *(f32x4*)(x1 + (size_t)row * 1024 + c) = v;
                        sq += (v[0] * v[0] + v[1] * v[1]) + (v[2] * v[2] + v[3] * v[3]);
                        const f32x4 a = v * gs[bj][n];
                        typedef unsigned u32x2v __attribute__((ext_vector_type(2)));
                        u32x2v w; w.x = cvt_pk_bf16(a[0], a[1]); w.y = cvt_pk_bf16(a[2], a[3]);
                        *(u32x2v*)(A2 + (size_t)row * 1024 + c) = w; }
                sq += __shfl_xor(sq, 16); sq += __shfl_xor(sq, 32);
                if (fq == 0) atomicAdd(ssq2 + row, sq); }
    }
};

struct EpiDown {
    static constexpr bool PERM = false, AFTER_DRAIN = false; static constexpr int MID_T = -1;
    float* x1; const float* modz; const float* b_ada; float* ssq3;
    __device__ __forceinline__ void mid(f32x4 (&)[2][2][4][2], const Unit&, int, int) const {}
    __device__ __forceinline__ void operator()(const f32x4 (&acc)[2][2][4][2], const Unit& u, int wr, int wc, int fr, int fq) const {
        const int mb = mb_of_tile(u.pm), col0 = u.pn * BM + wc * 32 + 4 * fq;
        f32x4 gate[2][2];
#pragma unroll
        for (int bj = 0; bj < 2; ++bj)
#pragma unroll
            for (int n = 0; n < 2; ++n) { const int c = col0 + bj * HALF + n * 16;
                gate[bj][n] = *(const f32x4*)(modz + mb * 6144 + 5 * 1024 + c) + *(const f32x4*)(b_ada + 5 * 1024 + c); }
#pragma unroll
        for (int ai = 0; ai < 2; ++ai)
#pragma unroll
            for (int m = 0; m < 4; ++m) { const int row = u.pm * BM + ai * HALF + wr * 64 + m * 16 + fr;
                float sq = 0.f;
#pragma unroll
                for (int bj = 0; bj < 2; ++bj)
#pragma unroll
                    for (int n = 0; n < 2; ++n) { const int c = col0 + bj * HALF + n * 16;
                        float* p = x1 + (size_t)row * 1024 + c;
                        const f32x4 v = *(const f32x4*)p + gate[bj][n] * acc[ai][bj][m][n];
                        *(f32x4*)p = v;
                        sq += (v[0] * v[0] + v[1] * v[1]) + (v[2] * v[2] + v[3] * v[3]); }
                sq += __shfl_xor(sq, 16); sq += __shfl_xor(sq, 32);
                if (fq == 0) atomicAdd(ssq3 + row, sq); }
    }
};
template <class Epi, class Sched, bool ALIGN_EPI = false, bool SP2 = false>
__device__ __forceinline__ void gemm_phase(PG8_LAS unsigned char* lds, const Gemm g, const Sched& S, const Epi& E) {
    int tid_ = threadIdx.x; asm volatile("" : "+v"(tid_)); const int tid = tid_, wid = __builtin_amdgcn_readfirstlane(tid >> 6), lane = tid & 63, wr = wid >> 2, wc = wid & 3, fr = lane & 15, fq = lane >> 4;
    const int K = g.K, nt = K / BK;
    unsigned voffA[2], voffB[2];
#pragma unroll
    for (int i = 0; i < 2; ++i) { int R, C; stage_rc(tid * 16 + i * 8192, R, C); const int Rb = Epi::PERM ? ((R & ~31) + perm32(R & 31)) : R;
        voffA[i] = (unsigned)(R * K + C) * 2u; voffB[i] = (unsigned)(Rb * K + C) * 2u; }
    const size_t kstep = (size_t)(BK * 2);
    const size_t hstep = (size_t)HALF * K * 2;
    const size_t tstep = 2 * hstep;
    const unsigned ldsw = (unsigned)wid * 1024u;
    const int aoff = lds_byte(wr * 64 + fr, fq * 8), boff = lds_byte(wc * 32 + fr, fq * 8);
#define PG8_SA(b, h) (((b) * 2 + (h)) * HTB)
#define PG8_SB(b, h) ((4 + (b) * 2 + (h)) * HTB)
#define PG8_STAGE(bufoff, gbase, voff) do { _Pragma("unroll") for (int _i = 0; _i < 2; ++_i) \
        __builtin_amdgcn_global_load_lds((const unsigned*)((const char*)(gbase) + (voff)[_i]), (PG8_LAS unsigned*)(lds + (bufoff) + ldsw + _i * 8192), 16, 0, 0); } while (0)
#define PG8_LDA(dst, b, h) do { _Pragma("unroll") for (int m = 0; m < 4; ++m) _Pragma("unroll") for (int k = 0; k < 2; ++k) dst[m][k] = *(const PG8_LAS bf16x8*)(lds + PG8_SA(b, h) + aoff + m * 2048 + k * 1024); } while (0)
#define PG8_LDB(dst, b, h) do { _Pragma("unroll") for (int n = 0; n < 2; ++n) _Pragma("unroll") for (int k = 0; k < 2; ++k) dst[n][k] = *(const PG8_LAS bf16x8*)(lds + PG8_SB(b, h) + boff + n * 2048 + k * 1024); } while (0)
#define PG8_MMA(ai, bj, At, Bt) do { __builtin_amdgcn_s_setprio(1); _Pragma("unroll") for (int m = 0; m < 4; ++m) _Pragma("unroll") for (int n = 0; n < 2; ++n) _Pragma("unroll") for (int k = 0; k < 2; ++k) \
        acc[ai][bj][m][n] = __builtin_amdgcn_mfma_f32_16x16x32_bf16(Bt[n][k], At[m][k], acc[ai][bj][m][n], 0, 0, 0); __builtin_amdgcn_s_setprio(0); } while (0)
#define PG8_WAIT_V(n) asm volatile("s_waitcnt vmcnt(" #n ")" ::: "memory")
#define PG8_WAIT_L(n) asm volatile("s_waitcnt lgkmcnt(" #n ")" ::: "memory")
#define PG8_BAR __builtin_amdgcn_s_barrier()
#define PG8_SCHED __builtin_amdgcn_sched_barrier(0)
    Unit cur, nxt; int ui = 0;
    if (!S.next(0, cur)) return;
    f32x4 acc[2][2][4][2];
#pragma unroll
    for (int a = 0; a < 2; ++a)
#pragma unroll
        for (int b = 0; b < 2; ++b)
#pragma unroll
            for (int m = 0; m < 4; ++m)
#pragma unroll
                for (int n = 0; n < 2; ++n) acc[a][b][m][n] = (f32x4){0.f, 0.f, 0.f, 0.f};
    bf16x8 At[4][2], B0[2][2], B1[2][2];
    const char* cA = (const char*)g.A + (size_t)cur.pm * tstep; const char* cB = (const char*)g.Bt + (size_t)cur.pn * tstep;
    S.a_ready(cur);
    if constexpr (SP2) {
        PG8_STAGE(PG8_SB(0, 0), cB, voffB); PG8_STAGE(PG8_SB(0, 1), cB + hstep, voffB); PG8_STAGE(PG8_SA(0, 0), cA, voffA); PG8_STAGE(PG8_SA(0, 1), cA + hstep, voffA);
        if (wr == 1) PG8_BAR;
        PG8_WAIT_V(2); PG8_BAR;
        PG8_STAGE(PG8_SB(1, 0), cB + kstep, voffB); PG8_STAGE(PG8_SA(1, 0), cA + kstep, voffA); PG8_STAGE(PG8_SB(1, 1), cB + hstep + kstep, voffB);
        PG8_WAIT_V(6); PG8_BAR;
    } else {
        PG8_STAGE(PG8_SB(0, 0), cB, voffB); PG8_STAGE(PG8_SA(0, 0), cA, voffA); PG8_STAGE(PG8_SB(0, 1), cB + hstep, voffB); PG8_STAGE(PG8_SA(0, 1), cA + hstep, voffA);
        if (wr == 1) PG8_BAR;
        PG8_WAIT_V(4); PG8_BAR;
        PG8_STAGE(PG8_SB(1, 0), cB + kstep, voffB); PG8_STAGE(PG8_SA(1, 0), cA + kstep, voffA); PG8_STAGE(PG8_SB(1, 1), cB + hstep + kstep, voffB);
        PG8_WAIT_V(6); PG8_BAR;
    }
    for (;;) {
        const bool has_next = S.next(ui + 1, nxt);
        const char* nA = has_next ? (const char*)g.A + (size_t)nxt.pm * tstep : cA; const char* nB = has_next ? (const char*)g.Bt + (size_t)nxt.pn * tstep : cB;
        for (int t = 0; t < nt; t += 2) {
            const bool last = (t == nt - 2);
            const char* a1 = cA + (size_t)(t + 1) * kstep;
            const char* a2 = last ? nA : cA + (size_t)(t + 2) * kstep; const char* b2 = last ? nB : cB + (size_t)(t + 2) * kstep;
            const char* a3 = a2 + kstep; const char* b3 = b2 + kstep;
            if (last && has_next) S.a_ready(nxt);
            if constexpr (Epi::MID_T >= 0) { if (t == Epi::MID_T) E.mid(acc, cur, wr, fr); }
            if constexpr (SP2) {
            PG8_LDB(B0, 0, 0); PG8_LDB(B1, 0, 1); PG8_SCHED; PG8_LDA(At, 0, 0); PG8_STAGE(PG8_SA(1, 1), a1 + hstep, voffA);
            PG8_WAIT_V(8); PG8_WAIT_L(0); PG8_BAR; PG8_MMA(0, 0, At, B0); PG8_MMA(0, 1, At, B1); PG8_BAR; PG8_SCHED;
            PG8_LDA(At, 0, 1); PG8_STAGE(PG8_SB(0, 0), b2, voffB); PG8_STAGE(PG8_SB(0, 1), b2 + hstep, voffB); PG8_STAGE(PG8_SA(0, 0), a2, voffA);
            PG8_WAIT_V(8); PG8_WAIT_L(0); PG8_BAR; PG8_MMA(1, 0, At, B0); PG8_MMA(1, 1, At, B1); PG8_BAR; PG8_SCHED;
            PG8_LDB(B0, 1, 0); PG8_LDB(B1, 1, 1); PG8_SCHED; PG8_LDA(At, 1, 0); PG8_STAGE(PG8_SA(0, 1), a2 + hstep, voffA);
            PG8_WAIT_V(8); PG8_WAIT_L(0); PG8_BAR; PG8_MMA(0, 0, At, B0); PG8_MMA(0, 1, At, B1); PG8_BAR; PG8_SCHED;
            PG8_LDA(At, 1, 1); PG8_STAGE(PG8_SB(1, 0), b3, voffB); PG8_STAGE(PG8_SB(1, 1), b3 + hstep, voffB); PG8_STAGE(PG8_SA(1, 0), a3, voffA);
            PG8_WAIT_V(8); PG8_WAIT_L(0); PG8_BAR; PG8_MMA(1, 0, At, B0); PG8_MMA(1, 1, At, B1); PG8_BAR; PG8_SCHED;
            } else {
            PG8_LDB(B0, 0, 0); PG8_SCHED; PG8_LDA(At, 0, 0); PG8_STAGE(PG8_SA(1, 1), a1 + hstep, voffA);
            PG8_WAIT_L(8); PG8_BAR; PG8_WAIT_L(0); PG8_MMA(0, 0, At, B0); PG8_BAR; PG8_SCHED;
            PG8_LDB(B1, 0, 1); PG8_STAGE(PG8_SB(0, 0), b2, voffB);
            PG8_BAR; PG8_WAIT_L(0); PG8_MMA(0, 1, At, B1); PG8_BAR;
            PG8_LDA(At, 0, 1); PG8_STAGE(PG8_SA(0, 0), a2, voffA);
            PG8_BAR; PG8_WAIT_L(0); PG8_MMA(1, 0, At, B0); PG8_BAR; PG8_SCHED;
            PG8_STAGE(PG8_SB(0, 1), b2 + hstep, voffB);
            PG8_WAIT_V(6); PG8_BAR; PG8_MMA(1, 1, At, B1); PG8_BAR;
            PG8_LDB(B0, 1, 0); PG8_SCHED; PG8_LDA(At, 1, 0); PG8_STAGE(PG8_SA(0, 1), a2 + hstep, voffA);
            PG8_WAIT_L(8); PG8_BAR; PG8_WAIT_L(0); PG8_MMA(0, 0, At, B0); PG8_BAR; PG8_SCHED;
            PG8_LDB(B1, 1, 1); PG8_STAGE(PG8_SB(1, 0), b3, voffB);
            PG8_BAR; PG8_WAIT_L(0); PG8_MMA(0, 1, At, B1); PG8_BAR;
            PG8_LDA(At, 1, 1); PG8_STAGE(PG8_SA(1, 0), a3, voffA);
            PG8_BAR; PG8_WAIT_L(0); PG8_MMA(1, 0, At, B0); PG8_BAR; PG8_SCHED;
            PG8_STAGE(PG8_SB(1, 1), b3 + hstep, voffB);
            PG8_WAIT_V(6); PG8_BAR; PG8_MMA(1, 1, At, B1); PG8_BAR;
            }
        }
        if constexpr (ALIGN_EPI) { if (wr == 0) PG8_BAR; }
        if constexpr (!Epi::AFTER_DRAIN) { E(acc, cur, wr, wc, fr, fq); S.done(cur); }
        if (!has_next) break;
#pragma unroll
        for (int a = 0; a < 2; ++a)
#pragma unroll
            for (int b = 0; b < 2; ++b)
#pragma unroll
                for (int m = 0; m < 4; ++m)
#pragma unroll
                    for (int n = 0; n < 2; ++n) acc[a][b][m][n] = (f32x4){0.f, 0.f, 0.f, 0.f};
        cur = nxt; cA = nA; cB = nB; ++ui;
        if constexpr (ALIGN_EPI) { if (wr == 1) PG8_BAR; }
    }
    PG8_WAIT_V(0);
    if constexpr (!ALIGN_EPI) { if (wr == 0) PG8_BAR; }
    PG8_BAR;
    if constexpr (Epi::AFTER_DRAIN) { E.fused(acc, cur, wr, wc, fr, fq, lds, wid, lane); S.done(cur); }
#undef PG8_SA
#undef PG8_SB
#undef PG8_STAGE
#undef PG8_LDA
#undef PG8_LDB
#undef PG8_MMA
#undef PG8_WAIT_V
#undef PG8_WAIT_L
#undef PG8_BAR
#undef PG8_SCHED
}
}
constexpr int NWAVES = 8, NTHR = 512;
constexpr int MTOK = 16384, DMOD = 1024, NPJ = 3072, NPROJ = 3088, DFF = 2816, NUP = 5632;
constexpr float EPS = 1e-6f;
constexpr size_t MiB = 1u << 20;
constexpr size_t WS_CTL = 0, CTL_ZERO_BYTES = 1 * MiB;
constexpr size_t WS_DT = 1 * MiB;
constexpr size_t WS_WIN = 2 * MiB, WS_WOUT = 8 * MiB, WS_WUP = 10 * MiB, WS_WDN = 21 * MiB;
constexpr size_t WS_AX = 32 * MiB;
constexpr size_t WS_PROJ = 64 * MiB;
constexpr size_t WS_A3 = 160 * MiB;
constexpr size_t WS_YF = 192 * MiB;
constexpr size_t WS_G = 64 * MiB;
constexpr size_t WS_U = 160 * MiB;
constexpr size_t WS_END = 256 * MiB;
static_assert(WS_WDN + (size_t)1024 * 2816 * 2 <= WS_AX && WS_G + (size_t)16384 * 2816 * 2 <= WS_U && WS_U + (size_t)8192 * 5632 * 2 <= WS_END, "ws map");
constexpr int CW_TMO = 0, CW_BAR = 4096, CW_MOD = 16384, CW_SSQY = 73728, CW_SSQ2 = 90112, CW_SSQ3 = 106496, CW_SV2 = 122880;
static_assert(CW_SV2 + 9 * 5632 <= (int)(CTL_ZERO_BYTES / 4), "ctl");
constexpr int LDS_SCRATCH = 153600, LDSCTL_OFF = LDS_SCRATCH, LDS_BYTES = 155648;

#define GAS __attribute__((address_space(1)))
#define LAS __attribute__((address_space(3)))
typedef unsigned short bf16;
typedef unsigned v4u __attribute__((ext_vector_type(4)));
typedef unsigned v2u __attribute__((ext_vector_type(2)));
typedef float f32x4 __attribute__((ext_vector_type(4)));
typedef float f32x16 __attribute__((ext_vector_type(16)));
typedef short bf16x8 __attribute__((ext_vector_type(8)));
typedef short s16x4 __attribute__((ext_vector_type(4)));
typedef float f32x2_t __attribute__((ext_vector_type(2)));
typedef __bf16 bf16x2_t __attribute__((ext_vector_type(2)));
#define LDS_WAIT() asm volatile("s_waitcnt lgkmcnt(0)" ::: "memory")
#define VM_WAIT() asm volatile("s_waitcnt vmcnt(0)" ::: "memory")
__device__ __forceinline__ unsigned pk2(float lo, float hi) { f32x2_t v = {lo, hi}; bf16x2_t b = __builtin_convertvector(v, bf16x2_t); return __builtin_bit_cast(unsigned, b); }
__device__ __forceinline__ float bflo(unsigned u) { return __uint_as_float(u << 16); }
__device__ __forceinline__ float bfhi(unsigned u) { return __uint_as_float(u & 0xffff0000u); }
__device__ __forceinline__ float silu_f(float x) { return x * __builtin_amdgcn_rcpf(1.f + __expf(-x)); }
__device__ __forceinline__ float softplus_f(float x) { return fmaxf(x, 0.f) + log1pf(__expf(-fabsf(x))); }
__device__ __forceinline__ float wave_sum(float v) {
#pragma unroll
    for (int o = 1; o < 64; o <<= 1) v += __shfl_xor(v, o);
    return v;
}

#define XB_TMO      128
#define XB_XCNT(j)  (256  + 64 * (j))
#define XB_XSUB(j)  (1280 + 64 * (j))
#define XB_XGEN(j)  (2304 + 64 * (j))
#define XB_TOP      3328
#define XB_TOPGEN   3392
#define XCD_BAR_WORDS 3456
#define XB_SPIN_CAP (1u << 18)
__device__ __forceinline__ unsigned xb_ld(unsigned* p)              { return __hip_atomic_load(p, __ATOMIC_RELAXED, __HIP_MEMORY_SCOPE_AGENT); }
__device__ __forceinline__ unsigned xb_add(unsigned* p, unsigned v) { return __hip_atomic_fetch_add(p, v, __ATOMIC_RELAXED, __HIP_MEMORY_SCOPE_AGENT); }
__device__ __forceinline__ unsigned xb_xcc_id() { return (unsigned)__builtin_amdgcn_s_getreg((3 << 11) | 20) & 0xFu; }
#define XB_SPIN(cond, bar) do { unsigned _sp = 0; while (cond) { __builtin_amdgcn_s_sleep(1); \
    if ((++_sp & 255u) == 0u) { if (xb_ld(&(bar)[XB_TMO])) break; if (_sp > XB_SPIN_CAP) { atomicAdd(&(bar)[XB_TMO], 1u); break; } } } } while (0)
struct XcdBarrier { unsigned* bar; unsigned x; volatile LAS unsigned* st; };
__device__ __forceinline__ XcdBarrier xcd_barrier_post(unsigned* bar, volatile LAS unsigned* st) {
    XcdBarrier b; b.bar = bar; b.x = xb_xcc_id(); b.st = st;
    if (threadIdx.x == 0) (void)xb_add(&bar[XB_XCNT(b.x)], 1u);
    return b;
}
__device__ __forceinline__ void xcd_barrier_complete(unsigned* bar, unsigned x, unsigned& nloc, unsigned& nx) {
    const unsigned G = gridDim.x * gridDim.y * gridDim.z;
    unsigned sum, cnt, mine, sp = 0u;
    for (;;) {
        sum = 0u; cnt = 0u; mine = 0u;
#pragma unroll
        for (unsigned j = 0; j < 16; ++j) { const unsigned c = xb_ld(&bar[XB_XCNT(j)]); sum += c; cnt += (c > 0u) ? 1u : 0u; mine = (j == x) ? c : mine; }
        if (sum == G) break;
        __builtin_amdgcn_s_sleep(1);
        if ((++sp & 255u) == 0u) { if (xb_ld(&bar[XB_TMO])) break; if (sp > XB_SPIN_CAP) { atomicAdd(&bar[XB_TMO], 1u); break; } }
    }
    nloc = mine > 0u ? mine : 1u; nx = cnt > 0u ? cnt : 1u;
}
__device__ __forceinline__ void xcd_barrier(const XcdBarrier& b) {
    asm volatile("s_waitcnt vmcnt(0)" ::: "memory");
    __syncthreads();
    if (threadIdx.x == 0) {
        unsigned* bar = b.bar;
        __builtin_amdgcn_s_waitcnt(0);
        unsigned nloc = b.st[0], nx = b.st[1];
        if (nloc == 0u) { xcd_barrier_complete(bar, b.x, nloc, nx); b.st[0] = nloc; b.st[1] = nx; }
        const unsigned old = xb_add(&bar[XB_XSUB(b.x)], 1u);
        const unsigned gen = old / nloc;
        if (old + 1u == (gen + 1u) * nloc) {
            __builtin_amdgcn_fence(__ATOMIC_RELEASE, "agent");
            asm volatile("s_waitcnt vmcnt(0)" ::: "memory");
            const unsigned og = xb_add(&bar[XB_TOP], 1u);
            const unsigned tg = og / nx;
            if (og + 1u == (tg + 1u) * nx) xb_add(&bar[XB_TOPGEN], 1u);
            else XB_SPIN(xb_ld(&bar[XB_TOPGEN]) == tg, bar);
            __builtin_amdgcn_fence(__ATOMIC_ACQUIRE, "agent");
            xb_add(&bar[XB_XGEN(b.x)], 1u);
            asm volatile("s_waitcnt vmcnt(0)" ::: "memory");
        } else {
            XB_SPIN(xb_ld(&bar[XB_XGEN(b.x)]) == gen, bar);
            __builtin_amdgcn_fence(__ATOMIC_ACQUIRE, "agent");
            asm volatile("s_waitcnt vmcnt(0)" ::: "memory");
        }
    }
    __syncthreads();
}

struct Args { const float* in[24]; float* out; unsigned char* ws; };
__device__ __forceinline__ int opaque_i(int x) { asm volatile("" : "+v"(x)); return x; }

__device__ __forceinline__ void transpose_item(const float* W, int ldw, int ks0, int n0, bf16* WT, int K, int kd0, LAS float* scr, int lane) {
#pragma unroll 8
    for (int i = 0; i < 32; ++i) { const int kk = 2 * i + (lane >> 5); scr[kk * 33 + (lane & 31)] = W[(size_t)(ks0 + kk) * ldw + n0 + (lane & 31)]; }
    LDS_WAIT(); asm volatile("" ::: "memory");
    const int c = lane & 7;
#pragma unroll
    for (int j = 0; j < 4; ++j) { const int n = (lane >> 3) + 8 * j; const LAS float* s = scr + (8 * c) * 33 + n;
        v4u o; o.x = pk2(s[0 * 33], s[1 * 33]); o.y = pk2(s[2 * 33], s[3 * 33]); o.z = pk2(s[4 * 33], s[5 * 33]); o.w = pk2(s[6 * 33], s[7 * 33]);
        *(GAS v4u*)(WT + (size_t)(n0 + n) * K + kd0 + 8 * c) = o; }
    LDS_WAIT(); asm volatile("" ::: "memory");
}

__device__ __forceinline__ void phase0(const Args& a, LAS unsigned char* lds, int tid, int lane, int wave, int vcu, int G) {
    const float *c = a.in[4], *c_ctx = a.in[5], *w_ada = a.in[8];
    float* modz = (float*)(a.ws + WS_CTL) + CW_MOD;
    LAS float* sc = (LAS float*)lds;
    for (int i = tid; i < 9 * 1024; i += NTHR) { const int mb = i >> 10, k = i & 1023; const float v = mb == 0 ? c_ctx[k] : c[(mb - 1) * 1024 + k]; sc[i] = silu_f(v); }
    __syncthreads();
    for (int it = blockIdx.x; it < 192; it += G) {
        const int cb = it % 12, kc = it / 12, col = cb * 512 + tid;
        float acc[9];
#pragma unroll
        for (int mb = 0; mb < 9; ++mb) acc[mb] = 0.f;
#pragma unroll 8
        for (int kk = 0; kk < 64; ++kk) { const int k = kc * 64 + kk; const float w = w_ada[(size_t)k * 6144 + col];
#pragma unroll
            for (int mb = 0; mb < 9; ++mb) acc[mb] += sc[mb * 1024 + k] * w; }
#pragma unroll
        for (int mb = 0; mb < 9; ++mb) atomicAdd(modz + mb * 6144 + col, acc[mb]);
    }
    LAS float* scr = (LAS float*)(lds + 40960 + wave * 8448);
    const int gw = vcu * NWAVES + wave, NGW = G * NWAVES;
    constexpr int I_IN = 16 * 96, I_OUT = 16 * 32, I_UP = 16 * 176, I_DN = 44 * 32, NITEMS = I_IN + I_OUT + I_UP + I_DN;
    bf16 *WinT = (bf16*)(a.ws + WS_WIN), *WoutT = (bf16*)(a.ws + WS_WOUT), *WupT = (bf16*)(a.ws + WS_WUP), *WdnT = (bf16*)(a.ws + WS_WDN);
    for (int it = gw; it < NITEMS; it += NGW) {
        int r = it;
        if (r < I_IN) { const int kb = r / 96, nb = r % 96; transpose_item(a.in[10], NPROJ, kb * 64, nb * 32, WinT, 1024, kb * 64, scr, lane); continue; } r -= I_IN;
        if (r < I_OUT) { const int kb = r / 32, nb = r % 32; transpose_item(a.in[18], 1024, (kb * 64 + 512) & 1023, nb * 32, WoutT, 1024, kb * 64, scr, lane); continue; } r -= I_OUT;
        if (r < I_UP) { const int kb = r / 176, nb = r % 176; transpose_item(a.in[19], NUP, kb * 64, nb * 32, WupT, 1024, kb * 64, scr, lane); continue; } r -= I_UP;
        { const int kb = r / 32, nb = r % 32; transpose_item(a.in[22], 1024, kb * 64, nb * 32, WdnT, DFF, kb * 64, scr, lane); }
    }
}

__device__ __forceinline__ void phase1(const Args& a, LAS unsigned char* lds, int tid, int lane, int wave, int vcu, int G) {
    const float* modz = (const float*)(a.ws + WS_CTL) + CW_MOD; const float* b_ada = a.in[9];
    float* sv2 = (float*)(a.ws + WS_CTL) + CW_SV2;
    {
        LAS float* shf = (LAS float*)(lds + 65536);
        const float* w_up = a.in[19];
        for (int it = blockIdx.x; it < 176; it += G) {
            const int cb = it % 11, kc = it / 11, col = cb * 512 + tid;
            __syncthreads();
            for (int i = tid; i < 9 * 64; i += NTHR) { const int mb = i >> 6, kk = i & 63; shf[i] = modz[mb * 6144 + 3 * 1024 + kc * 64 + kk] + b_ada[3 * 1024 + kc * 64 + kk]; }
            __syncthreads();
            float acc[9];
#pragma unroll
            for (int mb = 0; mb < 9; ++mb) acc[mb] = 0.f;
#pragma unroll 8
            for (int kk = 0; kk < 64; ++kk) { const float w = w_up[(size_t)(kc * 64 + kk) * NUP + col];
#pragma unroll
                for (int mb = 0; mb < 9; ++mb) acc[mb] += shf[mb * 64 + kk] * w; }
#pragma unroll
            for (int mb = 0; mb < 9; ++mb) atomicAdd(sv2 + mb * 5632 + col, acc[mb]);
        }
    }
    LAS float* wdt = (LAS float*)lds;
    { const float* w_in = a.in[10];
      for (int i = tid; i < 16384; i += NTHR) { const int cc = i >> 4, j = i & 15; wdt[j * 1024 + cc] = w_in[(size_t)cc * NPROJ + NPJ + j]; } }
    __syncthreads();
    const float* g1 = a.in[6]; const float* dt_bias = a.in[14];
    bf16* A1 = (bf16*)(a.ws + WS_AX); float* DT = (float*)(a.ws + WS_DT);
    const int gw = vcu * NWAVES + wave, NGW = G * NWAVES;
    for (int rb = gw; rb < MTOK / 8; rb += NGW) {
        const int row0 = rb * 8, mb = pg8::mb_of_tile(row0 >> 8);
        f32x4 gs[4], sh[4];
#pragma unroll
        for (int jj = 0; jj < 4; ++jj) { const int cc = 4 * lane + 256 * jj;
            gs[jj] = *(const f32x4*)(g1 + cc) * (*(const f32x4*)(modz + mb * 6144 + 1024 + cc) + *(const f32x4*)(b_ada + 1024 + cc) + 1.0f);
            sh[jj] = *(const f32x4*)(modz + mb * 6144 + cc) + *(const f32x4*)(b_ada + cc); }
        for (int rr = 0; rr < 8; ++rr) {
            const int row = row0 + rr;
            asm volatile("" ::: "memory");
            const float* xr = row < 8192 ? a.in[0] + (size_t)row * 1024 : a.in[1] + (size_t)(row - 8192) * 1024;
            f32x4 v[4]; float s = 0.f;
#pragma unroll
            for (int jj = 0; jj < 4; ++jj) { v[jj] = *(const f32x4*)(xr + 4 * lane + 256 * jj); s += (v[jj][0] * v[jj][0] + v[jj][1] * v[jj][1]) + (v[jj][2] * v[jj][2] + v[jj][3] * v[jj][3]); }
            const float r = __builtin_amdgcn_rsqf(wave_sum(s) * (1.0f / 1024.0f) + EPS);
#pragma unroll
            for (int jj = 0; jj < 4; ++jj) { v[jj] = (v[jj] * r) * gs[jj] + sh[jj];
                v2u o; o.x = pk2(v[jj][0], v[jj][1]); o.y = pk2(v[jj][2], v[jj][3]);
                *(GAS v2u*)(A1 + (size_t)row * 1024 + 4 * lane + 256 * jj) = o; }
            float mydt = 0.f;
#pragma unroll
            for (int j = 0; j < 16; ++j) { float p = 0.f;
#pragma unroll
                for (int jj = 0; jj < 4; ++jj) { const f32x4 w = *(const LAS f32x4*)(wdt + j * 1024 + 4 * lane + 256 * jj); p += (v[jj][0] * w[0] + v[jj][1] * w[1]) + (v[jj][2] * w[2] + v[jj][3] * w[3]); }
                p = wave_sum(p); if (lane == j) mydt = p; }
            if (lane < 16) DT[(size_t)row * 16 + lane] = softplus_f(mydt + dt_bias[lane]);
        }
    }
}

__device__ __forceinline__ void phase_xc(const Args& a, int lane, int gw, int NGW) {
    const bf16* PROJ = (const bf16*)(a.ws + WS_PROJ); bf16* XC = (bf16*)(a.ws + WS_AX); bf16* A3 = (bf16*)(a.ws + WS_A3);
    const float *w_cs = a.in[11], *w_cssd = a.in[12], *b_cssd = a.in[13];
    const v4u z4 = {0u, 0u, 0u, 0u};
    for (int id = gw; id < 2048 * 3; id += NGW) {
        const int run = id / 3, kind = id - run * 3, row0 = run * 8;
        const bool samp = row0 >= 8192; const int L = samp ? 1024 : 256, t0 = samp ? ((row0 - 8192) & 1023) : (row0 & 255);
        const bool has_prev = t0 > 0, has_next = t0 + 8 < L;
        if (kind < 2) {
            const int ch0 = kind * 512 + lane * 8; const bf16* src = PROJ + (size_t)row0 * NPJ + 2048 + ch0;
            v4u x[10];
            x[0] = has_prev ? *(const GAS v4u*)(src - NPJ) : z4;
#pragma unroll
            for (int rr = 0; rr < 8; ++rr) x[rr + 1] = *(const GAS v4u*)(src + (size_t)rr * NPJ);
            x[9] = has_next ? *(const GAS v4u*)(src + (size_t)8 * NPJ) : z4;
            float w[3][8], b[8];
#pragma unroll
            for (int k = 0; k < 3; ++k) { const f32x4 w0 = *(const f32x4*)(w_cssd + k * 1024 + ch0), w1 = *(const f32x4*)(w_cssd + k * 1024 + ch0 + 4);
                w[k][0] = w0[0]; w[k][1] = w0[1]; w[k][2] = w0[2]; w[k][3] = w0[3]; w[k][4] = w1[0]; w[k][5] = w1[1]; w[k][6] = w1[2]; w[k][7] = w1[3]; }
            { const f32x4 b0 = *(const f32x4*)(b_cssd + ch0), b1 = *(const f32x4*)(b_cssd + ch0 + 4); b[0] = b0[0]; b[1] = b0[1]; b[2] = b0[2]; b[3] = b0[3]; b[4] = b1[0]; b[5] = b1[1]; b[6] = b1[2]; b[7] = b1[3]; }
#pragma unroll
            for (int rr = 0; rr < 8; ++rr) { v4u o;
#pragma unroll
                for (int e2 = 0; e2 < 4; ++e2) {
                    const float lo = b[2 * e2] + w[0][2 * e2] * bflo(x[rr][e2]) + w[1][2 * e2] * bflo(x[rr + 1][e2]) + w[2][2 * e2] * bflo(x[rr + 2][e2]);
                    const float hi = b[2 * e2 + 1] + w[0][2 * e2 + 1] * bfhi(x[rr][e2]) + w[1][2 * e2 + 1] * bfhi(x[rr + 1][e2]) + w[2][2 * e2 + 1] * bfhi(x[rr + 2][e2]);
                    o[e2] = pk2(silu_f(lo), silu_f(hi)); }
                *(GAS v4u*)(XC + (size_t)(row0 + rr) * 1024 + ch0) = o; }
        } else {
            const int c0 = lane * 8; const bf16* src = PROJ + (size_t)row0 * NPJ + c0;
            v4u hc[10], gc[10], gb[8];
            hc[0] = has_prev ? *(const GAS v4u*)(src - NPJ) : z4; gc[0] = has_prev ? *(const GAS v4u*)(src - NPJ + 1024) : z4;
#pragma unroll
            for (int rr = 0; rr < 8; ++rr) { hc[rr + 1] = *(const GAS v4u*)(src + (size_t)rr * NPJ); gc[rr + 1] = *(const GAS v4u*)(src + (size_t)rr * NPJ + 1024); gb[rr] = *(const GAS v4u*)(src + (size_t)rr * NPJ + 512); }
            hc[9] = has_next ? *(const GAS v4u*)(src + (size_t)8 * NPJ) : z4; gc[9] = has_next ? *(const GAS v4u*)(src + (size_t)8 * NPJ + 1024) : z4;
            float w[3][8];
#pragma unroll
            for (int k = 0; k < 3; ++k) { const f32x4 w0 = *(const f32x4*)(w_cs + k * 512 + c0), w1 = *(const f32x4*)(w_cs + k * 512 + c0 + 4);
                w[k][0] = w0[0]; w[k][1] = w0[1]; w[k][2] = w0[2]; w[k][3] = w0[3]; w[k][4] = w1[0]; w[k][5] = w1[1]; w[k][6] = w1[2]; w[k][7] = w1[3]; }
#pragma unroll
            for (int rr = 0; rr < 8; ++rr) { v4u o;
#pragma unroll
                for (int e2 = 0; e2 < 4; ++e2) {
                    const float lo = w[0][2 * e2] * (bflo(hc[rr][e2]) * bflo(gc[rr][e2])) + w[1][2 * e2] * (bflo(hc[rr + 1][e2]) * bflo(gc[rr + 1][e2])) + w[2][2 * e2] * (bflo(hc[rr + 2][e2]) * bflo(gc[rr + 2][e2]));
                    const float hi = w[0][2 * e2 + 1] * (bfhi(hc[rr][e2]) * bfhi(gc[rr][e2])) + w[1][2 * e2 + 1] * (bfhi(hc[rr + 1][e2]) * bfhi(gc[rr + 1][e2])) + w[2][2 * e2 + 1] * (bfhi(hc[rr + 2][e2]) * bfhi(gc[rr + 2][e2]));
                    o[e2] = pk2(lo * bflo(gb[rr][e2]), hi * bfhi(gb[rr][e2])); }
                *(GAS v4u*)(A3 + (size_t)(row0 + rr) * 1024 + 512 + c0) = o; }
        }
    }
}

constexpr int O_IB = 0, O_IC = 32768, O_IX = 65536, O_SB = 81920, O_YS = 98304, O_CS = 133120, O_DTV = 133632, O_WG = 134144;
#define MFMA32(a, b, c) __builtin_amdgcn_mfma_f32_32x32x16_bf16((a), (b), (c), 0, 0, 0)
typedef short v4i16_t __attribute__((ext_vector_type(4)));
__device__ __forceinline__ int img_off(int row, int ch) { return row * 256 + ((ch ^ (row & 15)) << 4); }
__device__ __forceinline__ s16x4 lds_tr(LAS unsigned char* p) { return __builtin_bit_cast(s16x4, __builtin_amdgcn_ds_read_tr16_b64_v4i16((LAS v4i16_t*)p)); }
__device__ __forceinline__ s16x4 tr4(LAS unsigned char* img, bool swz, int r0, int c0, int lane) {
    const int blk = (lane >> 4) & 1, q = (lane & 15) >> 2, p = lane & 3, row = r0 + q, ch = (c0 >> 3) + 2 * blk + (p >> 1);
    return lds_tr(img + (swz ? img_off(row, ch) : row * 128 + (ch << 4)) + 8 * (p & 1));
}

__device__ __forceinline__ void ssd_stage(LAS unsigned char* lds, const bf16* XC, int row_base, int L, int dir, int k, int h, int g, int lane, int wave) {
#pragma unroll
    for (int i = 0; i < 4; ++i) { const int piece = wave * 4 + i, r = piece * 4 + (lane >> 4), s = lane & 15, c = s ^ (r & 15);
        const int j = k * 128 + r, t = dir ? L - 1 - j : j; const bf16* src = XC + (size_t)(row_base + t) * 1024 + 512 + g * 128 + c * 8;
        __builtin_amdgcn_global_load_lds((const unsigned*)src, (LAS unsigned*)(lds + O_IB + piece * 1024), 16, 0, 0);
        __builtin_amdgcn_global_load_lds((const unsigned*)(src + 256), (LAS unsigned*)(lds + O_IC + piece * 1024), 16, 0, 0); }
#pragma unroll
    for (int i = 0; i < 2; ++i) { const int piece = wave * 2 + i, r = piece * 8 + (lane >> 3), c = lane & 7;
        const int j = k * 128 + r, t = dir ? L - 1 - j : j; const bf16* src = XC + (size_t)(row_base + t) * 1024 + h * 64 + c * 8;
        __builtin_amdgcn_global_load_lds((const unsigned*)src, (LAS unsigned*)(lds + O_IX + piece * 1024), 16, 0, 0); }
}
__device__ __forceinline__ void ssd_scan(LAS unsigned char* lds, const float* DT, int row_base, int L, int dir, int k, int h, float aA, int lane) {
    LAS float* CS = (LAS float*)(lds + O_CS); LAS float* DTV = (LAS float*)(lds + O_DTV); LAS float* WG = (LAS float*)(lds + O_WG);
    const int j0 = k * 128 + 2 * lane, t0 = dir ? L - 1 - j0 : j0, t1 = dir ? t0 - 1 : t0 + 1;
    const float d0 = DT[(size_t)(row_base + t0) * 16 + dir * 8 + h], d1 = DT[(size_t)(row_base + t1) * 16 + dir * 8 + h];
    const float a0 = d0 * aA, a1 = d1 * aA, s = a0 + a1;
    float incl = s;
#pragma unroll
    for (int o = 1; o < 64; o <<= 1) { const float v = __shfl_up(incl, o); if (lane >= o) incl += v; }
    const float excl = incl - s, c0 = excl + a0, c1 = excl + s, cend = __shfl(incl, 63);
    CS[2 * lane] = c0; CS[2 * lane + 1] = c1; DTV[2 * lane] = d0; DTV[2 * lane + 1] = d1;
    WG[2 * lane] = d0 * __expf(cend - c0); WG[2 * lane + 1] = d1 * __expf(cend - c1);
}

__device__ __forceinline__ void ssd_unit(const Args& a, LAS unsigned char* lds, int tid, int lane, int wave, int seq, int h) {
    const bool samp = seq >= 32;
    const int L = samp ? 1024 : 256, nc = L >> 7, row_base = samp ? 8192 + (seq - 32) * 1024 : seq * 256, g = h >> 2;
    const bf16* PROJ = (const bf16*)(a.ws + WS_PROJ); const bf16* XC = (const bf16*)(a.ws + WS_AX);
    const float* DT = (const float*)(a.ws + WS_DT);
    bf16* A3 = (bf16*)(a.ws + WS_A3);
    float* YF = (float*)(a.ws + WS_YF) + (size_t)row_base * 512 + (size_t)h * 64 * L;
    float* ssqy = (float*)(a.ws + WS_CTL) + CW_SSQY;
    const float *a_log = a.in[15], *g_ssd = a.in[17];
    const float dskip = a.in[16][h];
    LAS float* CS = (LAS float*)(lds + O_CS); LAS float* DTV = (LAS float*)(lds + O_DTV); LAS float* WG = (LAS float*)(lds + O_WG);
    const int hh = lane >> 5, l31 = lane & 31;
    const int jt = wave >> 1, q = wave & 1;
    const int el = tid >> 2, eq = tid & 3;

    for (int dir = 0; dir < 2; ++dir) {
        const float aA = -__expf(a_log[dir * 8 + h]);
        f32x16 St;
        if (samp) { const float* init = a.in[2 + dir] + ((size_t)((seq - 32) * 8 + h) * 64 + 32 * q + l31) * 128 + 32 * jt;
#pragma unroll
            for (int gq = 0; gq < 4; ++gq) { const f32x4 v = *(const f32x4*)(init + 8 * gq + 4 * hh); St[4 * gq] = v[0]; St[4 * gq + 1] = v[1]; St[4 * gq + 2] = v[2]; St[4 * gq + 3] = v[3]; }
        } else {
#pragma unroll
            for (int i = 0; i < 16; ++i) St[i] = 0.f;
        }
        VM_WAIT();
        __syncthreads();
        if (wave == 0) ssd_scan(lds, DT, row_base, L, dir, 0, h, aA, lane);
        ssd_stage(lds, XC, row_base, L, dir, 0, h, g, lane, wave);
#pragma unroll
        for (int gq = 0; gq < 4; ++gq) { v2u o; o.x = pk2(St[4 * gq], St[4 * gq + 1]); o.y = pk2(St[4 * gq + 2], St[4 * gq + 3]);
            const int prow = 32 * q + l31, n0 = 32 * jt + 8 * gq + 4 * hh;
            *(LAS v2u*)(lds + O_SB + img_off(prow, n0 >> 3) + (n0 & 7) * 2) = o; }

        for (int k = 0; k < nc; ++k) {
            VM_WAIT();
            __syncthreads();
            int lz = lane; asm volatile("" : "+v"(lz)); const int hhz = lz >> 5, l31z = lz & 31;
            bf16x8 cf[8];
#pragma unroll
            for (int ks = 0; ks < 8; ++ks) cf[ks] = *(const LAS bf16x8*)(lds + O_IC + img_off(32 * jt + l31z, 2 * ks + hhz));
            f32x16 Y;
#pragma unroll
            for (int i = 0; i < 16; ++i) Y[i] = 0.f;
#pragma unroll
            for (int ks = 0; ks < 8; ++ks) { const bf16x8 sa = *(const LAS bf16x8*)(lds + O_SB + img_off(32 * q + l31z, 2 * ks + hhz)); Y = MFMA32(sa, cf[ks], Y); }
            const float csl = CS[32 * jt + l31z];
            { const float el_ = __expf(csl);
#pragma unroll
              for (int i = 0; i < 16; ++i) Y[i] *= el_; }
            for (int it = 0; it <= jt; ++it) {
                f32x16 Gt;
#pragma unroll
                for (int i = 0; i < 16; ++i) Gt[i] = 0.f;
#pragma unroll
                for (int ks = 0; ks < 8; ++ks) { const bf16x8 ba = *(const LAS bf16x8*)(lds + O_IB + img_off(32 * it + l31z, 2 * ks + hhz)); Gt = MFMA32(ba, cf[ks], Gt); }
                const bool dg = (it == jt);
#pragma unroll
                for (int gq = 0; gq < 4; ++gq) {
                    const f32x4 cs4 = *(const LAS f32x4*)(CS + 32 * it + 8 * gq + 4 * hhz), dt4 = *(const LAS f32x4*)(DTV + 32 * it + 8 * gq + 4 * hhz);
#pragma unroll
                    for (int e = 0; e < 4; ++e) { const int sl = 8 * gq + 4 * hhz + e;
                        float v = Gt[4 * gq + e] * dt4[e] * __expf(csl - cs4[e]);
                        if (dg) { if (sl > l31z) v = 0.f; if (dir == 0 && sl == l31z) v += dskip; }
                        Gt[4 * gq + e] = v; }
                }
#pragma unroll
                for (int st = 0; st < 2; ++st) {
                    v4u pb; pb.x = pk2(Gt[8 * st], Gt[8 * st + 1]); pb.y = pk2(Gt[8 * st + 2], Gt[8 * st + 3]); pb.z = pk2(Gt[8 * st + 4], Gt[8 * st + 5]); pb.w = pk2(Gt[8 * st + 6], Gt[8 * st + 7]);
                    const s16x4 xa0 = tr4(lds + O_IX, false, 32 * it + 16 * st + 4 * hhz, 32 * q, lz);
                    const s16x4 xa1 = tr4(lds + O_IX, false, 32 * it + 16 * st + 8 + 4 * hhz, 32 * q, lz);
                    const bf16x8 xa = __builtin_shufflevector(xa0, xa1, 0, 1, 2, 3, 4, 5, 6, 7);
                    Y = MFMA32(xa, __builtin_bit_cast(bf16x8, pb), Y);
                }
            }
            { const float cd = __expf(CS[127]);
#pragma unroll
              for (int i = 0; i < 16; ++i) St[i] *= cd; }
#pragma unroll
            for (int ks = 0; ks < 8; ++ks) {
                const s16x4 wa0 = tr4(lds + O_IB, true, 16 * ks + 8 * hhz, 32 * jt, lz), wa1 = tr4(lds + O_IB, true, 16 * ks + 8 * hhz + 4, 32 * jt, lz);
                const s16x4 xb0 = tr4(lds + O_IX, false, 16 * ks + 8 * hhz, 32 * q, lz), xb1 = tr4(lds + O_IX, false, 16 * ks + 8 * hhz + 4, 32 * q, lz);
                const f32x4 w0 = *(const LAS f32x4*)(WG + 16 * ks + 8 * hhz), w1 = *(const LAS f32x4*)(WG + 16 * ks + 8 * hhz + 4);
                const v2u x0 = __builtin_bit_cast(v2u, xb0), x1 = __builtin_bit_cast(v2u, xb1);
                v4u xs; xs.x = pk2(bflo(x0.x) * w0[0], bfhi(x0.x) * w0[1]); xs.y = pk2(bflo(x0.y) * w0[2], bfhi(x0.y) * w0[3]);
                xs.z = pk2(bflo(x1.x) * w1[0], bfhi(x1.x) * w1[1]); xs.w = pk2(bflo(x1.y) * w1[2], bfhi(x1.y) * w1[3]);
                const bf16x8 wa = __builtin_shufflevector(wa0, wa1, 0, 1, 2, 3, 4, 5, 6, 7);
                St = MFMA32(wa, __builtin_bit_cast(bf16x8, xs), St);
            }
            __syncthreads();
            int lq = lane; asm volatile("" : "+v"(lq)); const int hhq = lq >> 5, l31q = lq & 31;
            const int jl = k * 128 + 32 * jt + l31q, tl = dir ? L - 1 - jl : jl;
            const size_t erow = (size_t)row_base + (L - 1 - (k * 128 + el));
            v4u zq[2]; float yfv[16]; f32x4 gsv[4];
            if (dir == 1) {
#pragma unroll
                for (int i = 0; i < 4; ++i) gsv[i] = *(const f32x4*)(g_ssd + h * 64 + 16 * eq + 4 * i);
#pragma unroll
                for (int hv = 0; hv < 2; ++hv) zq[hv] = *(const GAS v4u*)(PROJ + erow * NPJ + 1536 + h * 64 + 16 * eq + 8 * hv);
#pragma unroll
                for (int i = 0; i < 16; ++i) { const int p = 32 * q + (i & 3) + 8 * (i >> 2) + 4 * hhq; yfv[i] = YF[(size_t)p * L + tl]; }
            }
            if (k + 1 < nc) { if (wave == 0) ssd_scan(lds, DT, row_base, L, dir, k + 1, h, aA, lq); ssd_stage(lds, XC, row_base, L, dir, k + 1, h, g, lq, wave); }
#pragma unroll
            for (int gq = 0; gq < 4; ++gq) { v2u o; o.x = pk2(St[4 * gq], St[4 * gq + 1]); o.y = pk2(St[4 * gq + 2], St[4 * gq + 3]);
                const int prow = 32 * q + l31q, n0 = 32 * jt + 8 * gq + 4 * hhq;
                *(LAS v2u*)(lds + O_SB + img_off(prow, n0 >> 3) + (n0 & 7) * 2) = o; }
            if (!samp && k == nc - 1) {
                float* so = a.out + (size_t)2 * 8192 * 1024 + (size_t)dir * 2097152 + ((size_t)(seq * 8 + h) * 64 + 32 * q + l31q) * 128 + 32 * jt;
#pragma unroll
                for (int gq = 0; gq < 4; ++gq) { f32x4 v = {St[4 * gq], St[4 * gq + 1], St[4 * gq + 2], St[4 * gq + 3]}; *(f32x4*)(so + 8 * gq + 4 * hhq) = v; }
            }
            if (dir == 0) {
#pragma unroll
                for (int i = 0; i < 16; ++i) { const int p = 32 * q + (i & 3) + 8 * (i >> 2) + 4 * hhq; YF[(size_t)p * L + tl] = Y[i]; }
            } else {
#pragma unroll
                for (int i = 0; i < 16; ++i) Y[i] += yfv[i];
                LAS float* YS = (LAS float*)(lds + O_YS);
#pragma unroll
                for (int gq = 0; gq < 4; ++gq) { f32x4 v = {Y[4 * gq], Y[4 * gq + 1], Y[4 * gq + 2], Y[4 * gq + 3]}; *(LAS f32x4*)(YS + (32 * jt + l31q) * 68 + 32 * q + 8 * gq + 4 * hhq) = v; }
                asm volatile("s_waitcnt lgkmcnt(0)" ::: "memory"); __builtin_amdgcn_s_barrier(); asm volatile("" ::: "memory");
                { const size_t row = erow; const int c0 = h * 64 + 16 * eq;
                  float sq = 0.f;
#pragma unroll
                  for (int hv = 0; hv < 2; ++hv) { const v4u z = zq[hv]; v4u o;
                      const f32x4 y0 = *(const LAS f32x4*)(YS + el * 68 + 16 * eq + 8 * hv), y1 = *(const LAS f32x4*)(YS + el * 68 + 16 * eq + 8 * hv + 4);
                      const f32x4 gg0 = gsv[2 * hv], gg1 = gsv[2 * hv + 1];
                      float yz[8];
                      yz[0] = y0[0] * silu_f(bflo(z[0])); yz[1] = y0[1] * silu_f(bfhi(z[0])); yz[2] = y0[2] * silu_f(bflo(z[1])); yz[3] = y0[3] * silu_f(bfhi(z[1]));
                      yz[4] = y1[0] * silu_f(bflo(z[2])); yz[5] = y1[1] * silu_f(bfhi(z[2])); yz[6] = y1[2] * silu_f(bflo(z[3])); yz[7] = y1[3] * silu_f(bfhi(z[3]));
#pragma unroll
                      for (int e = 0; e < 8; ++e) sq += yz[e] * yz[e];
                      o.x = pk2(yz[0] * gg0[0], yz[1] * gg0[1]); o.y = pk2(yz[2] * gg0[2], yz[3] * gg0[3]); o.z = pk2(yz[4] * gg1[0], yz[5] * gg1[1]); o.w = pk2(yz[6] * gg1[2], yz[7] * gg1[3]);
                      *(GAS v4u*)(A3 + row * 1024 + c0 + 8 * hv) = o; }
                  sq += __shfl_xor(sq, 1); sq += __shfl_xor(sq, 2);
                  if (eq == 0) atomicAdd(ssqy + row, sq); }
            }
        }
    }
}

__device__ __forceinline__ void phase3(const Args& a, LAS unsigned char* lds, int tid, int lane, int wave, int vcu, int G) {
    const int nrest = G - 64;
    if (nrest <= 0) { for (int u = vcu; u < 320; u += G) { const int seq = u < 64 ? 32 + (u >> 3) : (u - 64) >> 3, h = u & 7; ssd_unit(a, lds, tid, lane, wave, seq, h); } return; }
    if (vcu < 64) { ssd_unit(a, lds, tid, lane, wave, 32 + (vcu >> 3), vcu & 7); return; }
    for (int qn = vcu - 64; qn < 256; qn += nrest) ssd_unit(a, lds, tid, lane, wave, qn >> 3, qn & 7);
}
template <bool LAT>
__device__ __forceinline__ void ffn_issue(const bf16* U, LAS unsigned char* lds, int T, int buf, int lane, int wave) {
    constexpr int NS = LAT ? 54 : 34, NTILE = LAT ? 5632 : 2816, BUFB = 55296;
    const int cgb = T / (NTILE / 11), rest = T % (NTILE / 11);
    const size_t coff = (size_t)(lane < 32 ? cgb * 256 + lane * 8 : DFF + cgb * 256 + (lane - 32) * 8);
    for (int sl = wave; sl < NS; sl += 8) {
        int r;
        if (LAT) { const int bq = rest >> 6, gr = (rest >> 2) & 15, cb = rest & 3; int rr = gr + sl / 18 - 1, cc = cb * 16 - 1 + sl % 18;
            if (rr < 0 || rr > 15 || cc < 0 || cc > 63) { rr = gr; cc = cb * 16; }
            r = bq * 1024 + rr * 64 + cc;
        } else { const int sq = rest >> 3, tb = rest & 7; int tt = tb * 32 - 1 + sl; if (tt < 0 || tt > 255) tt = tb * 32; r = sq * 256 + tt; }
        __builtin_amdgcn_global_load_lds((const unsigned*)(U + (size_t)r * NUP + coff), (LAS unsigned*)(lds + buf * BUFB + sl * 1024), 16, 0, 0);
    }
}
template <bool LAT>
__device__ __forceinline__ void conv_ffn(const Args& a, LAS unsigned char* lds, int half, int lane, int wave, int cu, int G) {
    constexpr int NS = LAT ? 54 : 34, TPW = LAT ? 2 : 4, NTAP = LAT ? 9 : 3, NTILE = LAT ? 5632 : 2816, BUFB = 55296;
    const bf16* U = (const bf16*)(a.ws + WS_U); bf16* Gb = (bf16*)(a.ws + WS_G) + (size_t)half * 8192 * DFF;
    const float* wf = a.in[20]; const float* bfc = a.in[21];
    const int T0 = (int)((long)cu * NTILE / G), T1 = (int)((long)(cu + 1) * NTILE / G);
    float w[NTAP][2][4], b[2][4]; int cgb_cur = -1;
    if (T0 < T1) ffn_issue<LAT>(U, lds, T0, 0, lane, wave);
    for (int T = T0; T < T1; ++T) {
        const int buf = (T - T0) & 1;
        VM_WAIT();
        __syncthreads();
        if (T + 1 < T1) ffn_issue<LAT>(U, lds, T + 1, buf ^ 1, lane, wave);
        const int cgb = T / (NTILE / 11), rest = T % (NTILE / 11), c = cgb * 256 + lane * 4;
        if (cgb != cgb_cur) { cgb_cur = cgb;
#pragma unroll
            for (int tp = 0; tp < NTAP; ++tp)
#pragma unroll
                for (int s = 0; s < 2; ++s) { const f32x4 v = *(const f32x4*)(wf + (size_t)(LAT ? tp : 3 + tp) * NUP + s * DFF + c); w[tp][s][0] = v[0]; w[tp][s][1] = v[1]; w[tp][s][2] = v[2]; w[tp][s][3] = v[3]; }
#pragma unroll
            for (int s = 0; s < 2; ++s) { const f32x4 v = *(const f32x4*)(bfc + s * DFF + c); b[s][0] = v[0]; b[s][1] = v[1]; b[s][2] = v[2]; b[s][3] = v[3]; }
        }
        LAS unsigned char* base = lds + buf * BUFB + lane * 8;
#pragma unroll
        for (int tt = 0; tt < TPW; ++tt) {
            const int o = wave * TPW + tt;
            float acc[2][4];
#pragma unroll
            for (int s = 0; s < 2; ++s)
#pragma unroll
                for (int e = 0; e < 4; ++e) acc[s][e] = b[s][e];
            int rout;
            if (LAT) { const int bq = rest >> 6, gr = (rest >> 2) & 15, cb = rest & 3, gc = cb * 16 + o; rout = bq * 1024 + gr * 64 + gc;
#pragma unroll
                for (int di = 0; di < 3; ++di)
#pragma unroll
                    for (int dj = 0; dj < 3; ++dj) { const int rr = gr + di - 1, c2 = gc + dj - 1;
                        if (rr >= 0 && rr < 16 && c2 >= 0 && c2 < 64) { const LAS unsigned char* sp = base + (di * 18 + o + dj) * 1024;
#pragma unroll
                            for (int s = 0; s < 2; ++s) { const v2u v = *(const LAS v2u*)(sp + s * 512);
                                acc[s][0] += w[di * 3 + dj][s][0] * bflo(v.x); acc[s][1] += w[di * 3 + dj][s][1] * bfhi(v.x); acc[s][2] += w[di * 3 + dj][s][2] * bflo(v.y); acc[s][3] += w[di * 3 + dj][s][3] * bfhi(v.y); } } }
            } else { const int sq = rest >> 3, tb = rest & 7, tk = tb * 32 + o; rout = sq * 256 + tk;
#pragma unroll
                for (int dj = 0; dj < 3; ++dj) { const int t2 = tk + dj - 1;
                    if (t2 >= 0 && t2 < 256) { const LAS unsigned char* sp = base + (o + dj) * 1024;
#pragma unroll
                        for (int s = 0; s < 2; ++s) { const v2u v = *(const LAS v2u*)(sp + s * 512);
                            acc[s][0] += w[dj][s][0] * bflo(v.x); acc[s][1] += w[dj][s][1] * bfhi(v.x); acc[s][2] += w[dj][s][2] * bflo(v.y); acc[s][3] += w[dj][s][3] * bfhi(v.y); } } }
            }
            v2u ov; ov.x = pk2(silu_f(acc[0][0]) * acc[1][0], silu_f(acc[0][1]) * acc[1][1]); ov.y = pk2(silu_f(acc[0][2]) * acc[1][2], silu_f(acc[0][3]) * acc[1][3]);
            *(GAS v2u*)(Gb + (size_t)rout * DFF + c) = ov;
        }
    }
    VM_WAIT();
    __syncthreads();
}
__device__ __forceinline__ void phase8(const Args& a, int lane, int gw, int NGW) {
    const float* ssq3 = (const float*)(a.ws + WS_CTL) + CW_SSQ3; const float* gf = a.in[23];
    f32x4 g4[4];
#pragma unroll
    for (int jj = 0; jj < 4; ++jj) g4[jj] = *(const f32x4*)(gf + 4 * lane + 256 * jj);
    for (int rb = gw; rb < MTOK / 8; rb += NGW)
        for (int rr = 0; rr < 8; ++rr) { const int row = rb * 8 + rr; float* xr = a.out + (size_t)row * 1024;
            const float r = __builtin_amdgcn_rsqf(ssq3[row] * (1.0f / 1024.0f) + EPS);
#pragma unroll
            for (int jj = 0; jj < 4; ++jj) { const f32x4 v = *(const f32x4*)(xr + 4 * lane + 256 * jj); *(f32x4*)(xr + 4 * lane + 256 * jj) = (v * r) * g4[jj]; } }
}

__global__ void __launch_bounds__(NTHR, 2) mega_fwd(Args a) {
    extern __shared__ __attribute__((aligned(16))) unsigned char lds_raw[];
    LAS unsigned char* lds = (LAS unsigned char*)lds_raw;
#define PH_IDS const int tid = opaque_i((int)threadIdx.x), lane = tid & 63, wave = __builtin_amdgcn_readfirstlane(tid >> 6); const int gw = vcu * NWAVES + wave; (void)gw; (void)lane;
    const int G = gridDim.x; const int bx = blockIdx.x; const int vcu = (G % 8 == 0) ? (bx % 8) * (G / 8) + bx / 8 : bx;
    const int NGW = G * NWAVES;
    unsigned* ctl = (unsigned*)(a.ws + WS_CTL); float* ctlf = (float*)ctl;
    for (int u = threadIdx.x; u < (LDS_BYTES - LDSCTL_OFF) / 4; u += NTHR) ((LAS unsigned*)(lds + LDSCTL_OFF))[u] = 0u;
    __syncthreads();
    XcdBarrier bar = xcd_barrier_post(ctl + CW_BAR, (volatile LAS unsigned*)(lds + LDSCTL_OFF + 64));
#ifdef PROBE_MASK
    unsigned long long pr_t = __builtin_amdgcn_s_memrealtime(), pr_extra = 0ull; int pr_seg = 0;
#define SEG_END() do { const unsigned long long t_ = __builtin_amdgcn_s_memrealtime(); if ((PROBE_MASK >> pr_seg) & 1) pr_extra += t_ - pr_t; pr_t = t_; ++pr_seg; } while (0)
#else
#define SEG_END() do { } while (0)
#endif

#ifndef NO_P0
    { PH_IDS phase0(a, lds, tid, lane, wave, vcu, G); }
#endif
    xcd_barrier(bar); SEG_END();
#ifndef NO_P1
    { PH_IDS phase1(a, lds, tid, lane, wave, vcu, G); }
#endif
    xcd_barrier(bar); SEG_END();
    {
        pg8::Gemm g{(const pg8::bf16_t*)(a.ws + WS_AX), (const pg8::bf16_t*)(a.ws + WS_WIN), MTOK, NPJ, 1024}; pg8::StaticOrder S; S.init(MTOK, NPJ, G, bx);
        pg8::EpiPlainBf16 E{(pg8::bf16_t*)(a.ws + WS_PROJ), NPJ};
#ifndef NO_G2
        pg8::gemm_phase<pg8::EpiPlainBf16, pg8::StaticOrder, true, true>(lds, g, S, E);
#endif
    }
    xcd_barrier(bar); SEG_END();
#ifndef NO_PXC
    { PH_IDS phase_xc(a, lane, gw, NGW); }
#endif
    xcd_barrier(bar); SEG_END();
#ifndef NO_P3
    { PH_IDS phase3(a, lds, tid, lane, wave, vcu, G); }
#endif
    xcd_barrier(bar); SEG_END();
    {
        pg8::Gemm g{(const pg8::bf16_t*)(a.ws + WS_A3), (const pg8::bf16_t*)(a.ws + WS_WOUT), MTOK, 1024, 1024}; pg8::StaticOrder S; S.init(MTOK, 1024, G, bx);
        pg8::EpiOut E{a.in[0], a.in[1], a.out, (pg8::bf16_t*)(a.ws + WS_AX), ctlf + CW_MOD, a.in[9], a.in[7], ctlf + CW_SSQ2, ctlf + CW_SSQY};
#ifndef NO_G4
        pg8::gemm_phase<pg8::EpiOut, pg8::StaticOrder, true, true>(lds, g, S, E);
#endif
    }
    xcd_barrier(bar); SEG_END();
    for (int half = 0; half < 2; ++half) {
        {
            pg8::Gemm g{(const pg8::bf16_t*)(a.ws + WS_AX) + (size_t)half * 8192 * 1024, (const pg8::bf16_t*)(a.ws + WS_WUP), 8192, NUP, 1024}; pg8::StaticOrder S; S.init(8192, NUP, G, bx);
            pg8::EpiUp E{(pg8::bf16_t*)(a.ws + WS_U), ctlf + CW_SSQ2, ctlf + CW_SV2, half * 32};
#ifndef NO_G5
            pg8::gemm_phase<pg8::EpiUp, pg8::StaticOrder, true, true>(lds, g, S, E);
#endif
        }
        xcd_barrier(bar); SEG_END();
#ifndef NO_P6
        { PH_IDS if (half == 0) conv_ffn<false>(a, lds, 0, lane, wave, vcu, G); else conv_ffn<true>(a, lds, 1, lane, wave, vcu, G); }
#endif
        xcd_barrier(bar); SEG_END();
    }
    {
        pg8::Gemm g{(const pg8::bf16_t*)(a.ws + WS_G), (const pg8::bf16_t*)(a.ws + WS_WDN), MTOK, 1024, DFF}; pg8::StaticOrder S; S.init(MTOK, 1024, G, bx);
        pg8::EpiDown E{a.out, ctlf + CW_MOD, a.in[9], ctlf + CW_SSQ3};
#ifndef NO_G7
        pg8::gemm_phase<pg8::EpiDown, pg8::StaticOrder, true, true>(lds, g, S, E);
#endif
    }
    xcd_barrier(bar); SEG_END();
#ifndef NO_P8
    { PH_IDS phase8(a, lane, gw, NGW); }
#endif
#ifdef PROBE_MASK
    SEG_END();
    if (blockIdx.x == 0 && threadIdx.x == 0) { const unsigned long long t0_ = __builtin_amdgcn_s_memrealtime(); while (__builtin_amdgcn_s_memrealtime() - t0_ < pr_extra) __builtin_amdgcn_s_sleep(8); }
#endif
}

extern "C" void kernel_launch(void* const* d_in, const int* in_sizes, int n_in, void* d_out, int out_size, void* d_ws, size_t ws_size, hipStream_t stream) {
    static int grid = 0;
    if (grid == 0) {
        if (n_in != 24 || ws_size < WS_END) { fprintf(stderr, "kernel_launch: unexpected problem (n_in %d, ws %zu)\n", n_in, ws_size); grid = -1; return; }
        int dev = 0, cus = 0, per_cu = 0;
        if (hipGetDevice(&dev) != hipSuccess || hipDeviceGetAttribute(&cus, hipDeviceAttributeMultiprocessorCount, dev) != hipSuccess) { grid = -1; return; }
        if (hipFuncSetAttribute((const void*)mega_fwd, hipFuncAttributeMaxDynamicSharedMemorySize, LDS_BYTES) != hipSuccess) { fprintf(stderr, "kernel_launch: hipFuncSetAttribute failed\n"); grid = -1; return; }
        if (hipOccupancyMaxActiveBlocksPerMultiprocessor(&per_cu, (const void*)mega_fwd, NTHR, LDS_BYTES) != hipSuccess || per_cu < 1) { fprintf(stderr, "kernel_launch: occupancy query says %d\n", per_cu); per_cu = 1; }
        (void)hipGetLastError();
        grid = cus;
    }
    if (grid < 0) return;
    (void)hipMemsetAsync((char*)d_ws + WS_CTL, 0, CTL_ZERO_BYTES, stream);
    Args a{};
    for (int i = 0; i < 24; ++i) a.in[i] = (const float*)d_in[i];
    a.out = (float*)d_out; a.ws = (unsigned char*)d_ws;
    hipLaunchKernelGGL(mega_fwd, dim3(grid), dim3(NTHR), LDS_BYTES, stream, a);
}
```

```cpp
#include <hip/hip_runtime.h>
#include <cstdio>
#include <cstdint>
namespace pg8 {
#define PG8_LAS __attribute__((address_space(3)))
typedef unsigned short bf16_t;
typedef short bf16x8 __attribute__((ext_vector_type(8)));
typedef float f32x4 __attribute__((ext_vector_type(4)));
typedef unsigned u32x4 __attribute__((ext_vector_type(4)));
constexpr int BM = 256, BK = 64, HALF = 128, HTB = HALF * BK * 2  , STAGE_BYTES = 8 * HTB, NXCD = 8, WGM = 8;

__host__ __device__ __forceinline__ int lds_byte(int r, int c) { const int st = (r >> 4) * 2 + (c >> 5), rr = r & 15, cc = c & 31, ob = rr * 64 + cc * 2; return st * 1024 + (ob ^ (((ob >> 9) & 1) << 5)); }
__host__ __device__ __forceinline__ void stage_rc(int b, int& R, int& C) { const int st = b / 1024, sb = b % 1024, swz = sb ^ (((sb >> 9) & 1) << 5); R = (st >> 1) * 16 + swz / 64; C = (st & 1) * 32 + (swz % 64) / 2; }
__host__ __device__ __forceinline__ int perm32(int rho) { const int n = rho >> 4, i = rho & 15; return 8 * (i >> 2) + 4 * n + (i & 3); }

struct Unit { int pm, pn; };
struct Gemm { const bf16_t* A; const bf16_t* Bt; int M, N, K; };

struct StaticOrder {
    int nM, nN, nwg, G, c;
    __host__ __device__ void init(int M, int N, int G_, int c_) { nM = M / BM; nN = N / BM; nwg = nM * nN; G = G_; c = c_; }
    __host__ __device__ bool next(int i, Unit& u) const {
        const long L = (long)i * G + c; if (L >= nwg) return false;
        int wgid = (int)L; { const int q = nwg / NXCD, r = nwg % NXCD, xcd = wgid % NXCD, off = wgid / NXCD; wgid = (xcd < r ? xcd * (q + 1) : r * (q + 1) + (xcd - r) * q) + off; }
        const int nig = WGM * nN, gid = wgid / nig, fm = gid * WGM, gsz = (nM - fm) < WGM ? (nM - fm) : WGM;
        u.pm = fm + ((wgid % nig) % gsz); u.pn = (wgid % nig) / gsz; return true;
    }
    __device__ __forceinline__ void a_ready(const Unit&) const {}
    __device__ __forceinline__ void done(const Unit&) const {}
};

__device__ __forceinline__ unsigned cvt_pk_bf16(float lo, float hi) { unsigned r; asm volatile("v_cvt_pk_bf16_f32 %0, %1, %2" : "=v"(r) : "v"(lo), "v"(hi)); return r; }
constexpr float RMS_EPS = 1e-6f;
__device__ __forceinline__ int mb_of_tile(int gpm) { return gpm < 32 ? 0 : 1 + ((gpm - 32) >> 2); }

struct EpiPlainBf16 {
    static constexpr bool PERM = true, AFTER_DRAIN = false; static constexpr int MID_T = -1;
    bf16_t* O; int ldc;
    __device__ __forceinline__ void mid(f32x4 (&)[2][2][4][2], const Unit&, int, int) const {}
    __device__ __forceinline__ void operator()(const f32x4 (&acc)[2][2][4][2], const Unit& u, int wr, int wc, int fr, int fq) const {
        const int row0 = u.pm * BM + wr * 64 + fr, col0 = u.pn * BM + wc * 32 + 8 * fq;
#pragma unroll
        for (int ai = 0; ai < 2; ++ai)
#pragma unroll
            for (int m = 0; m < 4; ++m) { bf16_t* rowp = O + (size_t)(row0 + ai * HALF + m * 16) * ldc + col0;
#pragma unroll
                for (int bj = 0; bj < 2; ++bj) { const f32x4 v0 = acc[ai][bj][m][0], v1 = acc[ai][bj][m][1];
                    u32x4 w; w.x = cvt_pk_bf16(v0[0], v0[1]); w.y = cvt_pk_bf16(v0[2], v0[3]); w.z = cvt_pk_bf16(v1[0], v1[1]); w.w = cvt_pk_bf16(v1[2], v1[3]);
                    *(u32x4*)(rowp + bj * HALF) = w; } }
    }
};

struct EpiUp {
    static constexpr bool PERM = true, AFTER_DRAIN = false; static constexpr int MID_T = -1;
    bf16_t* O; const float* ssq; const float* sv; int tile0;
    __device__ __forceinline__ void mid(f32x4 (&)[2][2][4][2], const Unit&, int, int) const {}
    __device__ __forceinline__ void operator()(const f32x4 (&acc)[2][2][4][2], const Unit& u, int wr, int wc, int fr, int fq) const {
        const int gpm = tile0 + u.pm, mb = mb_of_tile(gpm);
        const int lrow0 = u.pm * BM + wr * 64 + fr, col0 = u.pn * BM + wc * 32 + 8 * fq;
        f32x4 bv[2][2];
#pragma unroll
        for (int bj = 0; bj < 2; ++bj)
#pragma unroll
            for (int n = 0; n < 2; ++n) bv[bj][n] = *(const f32x4*)(sv + (size_t)mb * 5632 + col0 + bj * HALF + 4 * n);
#pragma unroll
        for (int ai = 0; ai < 2; ++ai)
#pragma unroll
            for (int m = 0; m < 4; ++m) { const int lrow = lrow0 + ai * HALF + m * 16;
                const float r = __builtin_amdgcn_rsqf(ssq[(size_t)tile0 * BM + lrow] * (1.0f / 1024.0f) + RMS_EPS);
                bf16_t* rowp = O + (size_t)lrow * 5632 + col0;
#pragma unroll
                for (int bj = 0; bj < 2; ++bj) { const f32x4 v0 = acc[ai][bj][m][0] * r + bv[bj][0], v1 = acc[ai][bj][m][1] * r + bv[bj][1];
                    u32x4 w; w.x = cvt_pk_bf16(v0[0], v0[1]); w.y = cvt_pk_bf16(v0[2], v0[3]); w.z = cvt_pk_bf16(v1[0], v1[1]); w.w = cvt_pk_bf16(v1[2], v1[3]);
                    *(u32x4*)(rowp + bj * HALF) = w; } }
    }
};

struct EpiOut {
    static constexpr bool PERM = false, AFTER_DRAIN = false; static constexpr int MID_T = -1;
    const float* xp; const float* xs; float* x1; bf16_t* A2; const float* modz; const float* b_ada; const float* g2; float* ssq2; const float* ssqy;
    __device__ __forceinline__ void mid(f32x4 (&acc)[2][2][4][2], const Unit& u, int wr, int fr) const {
#pragma unroll
        for (int ai = 0; ai < 2; ++ai)
#pragma unroll
            for (int m = 0; m < 4; ++m) { const int row = u.pm * BM + ai * HALF + wr * 64 + m * 16 + fr;
                const float ry = __builtin_amdgcn_rsqf(ssqy[row] * (1.0f / 512.0f) + RMS_EPS);
#pragma unroll
                for (int bj = 0; bj < 2; ++bj)
#pragma unroll
                    for (int n = 0; n < 2; ++n) acc[ai][bj][m][n] = acc[ai][bj][m][n] * ry; }
    }
    __device__ __forceinline__ void operator()(const f32x4 (&acc)[2][2][4][2], const Unit& u, int wr, int wc, int fr, int fq) const {
        const int mb = mb_of_tile(u.pm), col0 = u.pn * BM + wc * 32 + 4 * fq;
        f32x4 gate[2][2], gs[2][2];
#pragma unroll
        for (int bj = 0; bj < 2; ++bj)
#pragma unroll
            for (int n = 0; n < 2; ++n) { const int c = col0 + bj * HALF + n * 16;
                gate[bj][n] = *(const f32x4*)(modz + mb * 6144 + 2 * 1024 + c) + *(const f32x4*)(b_ada + 2 * 1024 + c);
                gs[bj][n] = *(const f32x4*)(g2 + c) * (*(const f32x4*)(modz + mb * 6144 + 4 * 1024 + c) + *(const f32x4*)(b_ada + 4 * 1024 + c) + 1.0f); }
#pragma unroll
        for (int ai = 0; ai < 2; ++ai)
#pragma unroll
            for (int m = 0; m < 4; ++m) { const int row = u.pm * BM + ai * HALF + wr * 64 + m * 16 + fr;
                const float* xr = row < 8192 ? xp + (size_t)row * 1024 : xs + (size_t)(row - 8192) * 1024;
                float sq = 0.f;
#pragma unroll
                for (int bj = 0; bj < 2; ++bj)
#pragma unroll
                    for (int n = 0; n < 2; ++n) { const int c = col0 + bj * HALF + n * 16;
                        const f32x4 v = *(const f32x4*)(xr + c) + gate[bj][n] * acc[ai][bj][m][n];
                        *(f32x4*)(x1 + (size_t)row * 1024 + c) = v;
                        sq += (v[0] * v[0] + v[1] * v[1]) + (v[2] * v[2] + v[3] * v[3]);
                        const f32x4 a = v * gs[bj][n];
                        typedef unsigned u32x2v __attribute__((ext_vector_type(2)));
                        u32x2v w; w.x = cvt_pk_bf16(a[0], a[1]); w.y = cvt_pk_bf16(a[2], a[3]);
                        *(u32x2v*)(A2 + (size_t)row * 1024 + c) = w; }
                sq += __shfl_xor(sq, 16); sq += __shfl_xor(sq, 32);
                if (fq == 0) atomicAdd(ssq2 + row, sq); }
    }
};

struct EpiDown {
    static constexpr bool PERM = false, AFTER_DRAIN = false; static constexpr int MID_T = -1;
    float* x1; const float* modz; const float* b_ada; float* ssq3;
    __device__ __forceinline__ void mid(f32x4 (&)[2][2][4][2], const Unit&, int, int) const {}
    __device__ __forceinline__ void operator()(const f32x4 (&acc)[2][2][4][2], const Unit& u, int wr, int wc, int fr, int fq) const {
        const int mb = mb_of_tile(u.pm), col0 = u.pn * BM + wc * 32 + 4 * fq;
        f32x4 gate[2][2];
#pragma unroll
        for (int bj = 0; bj < 2; ++bj)
#pragma unroll
            for (int n = 0; n < 2; ++n) { const int c = col0 + bj * HALF + n * 16;
                gate[bj][n] = *(const f32x4*)(modz + mb * 6144 + 5 * 1024 + c) + *(const f32x4*)(b_ada + 5 * 1024 + c); }
#pragma unroll
        for (int ai = 0; ai < 2; ++ai)
#pragma unroll
            for (int m = 0; m < 4; ++m) { const int row = u.pm * BM + ai * HALF + wr * 64 + m * 16 + fr;
                float sq = 0.f;
#pragma unroll
                for (int bj = 0; bj < 2; ++bj)
#pragma unroll
                    for (int n = 0; n < 2; ++n) { const int c = col0 + bj * HALF + n * 16;
                        float* p = x1 + (size_t)row * 1024 + c;
                        const f32x4 v = *(const f32x4*)p + gate[bj][n] * acc[ai][bj][m][n];
                        *(f32x4*)p = v;
                        sq += (v[0] * v[0] + v[1] * v[1]) + (v[2] * v[2] + v[3] * v[3]); }
                sq += __shfl_xor(sq, 16); sq += __shfl_xor(sq, 32);
                if (fq == 0) atomicAdd(ssq3 + row, sq); }
    }
};
template <class Epi, class Sched, bool ALIGN_EPI = false, bool SP2 = false>
__device__ __forceinline__ void gemm_phase(PG8_LAS unsigned char* lds, const Gemm g, const Sched& S, const Epi& E) {
    int tid_ = threadIdx.x; asm volatile("" : "+v"(tid_)); const int tid = tid_, wid = __builtin_amdgcn_readfirstlane(tid >> 6), lane = tid & 63, wr = wid >> 2, wc = wid & 3, fr = lane & 15, fq = lane >> 4;
    const int K = g.K, nt = K / BK;
    unsigned voffA[2], voffB[2];
#pragma unroll
    for (int i = 0; i < 2; ++i) { int R, C; stage_rc(tid * 16 + i * 8192, R, C); const int Rb = Epi::PERM ? ((R & ~31) + perm32(R & 31)) : R;
        voffA[i] = (unsigned)(R * K + C) * 2u; voffB[i] = (unsigned)(Rb * K + C) * 2u; }
    const size_t kstep = (size_t)(BK * 2);
    const size_t hstep = (size_t)HALF * K * 2;
    const size_t tstep = 2 * hstep;
    const unsigned ldsw = (unsigned)wid * 1024u;
    const int aoff = lds_byte(wr * 64 + fr, fq * 8), boff = lds_byte(wc * 32 + fr, fq * 8);
#define PG8_SA(b, h) (((b) * 2 + (h)) * HTB)
#define PG8_SB(b, h) ((4 + (b) * 2 + (h)) * HTB)
#define PG8_STAGE(bufoff, gbase, voff) do { _Pragma("unroll") for (int _i = 0; _i < 2; ++_i) \
        __builtin_amdgcn_global_load_lds((const unsigned*)((const char*)(gbase) + (voff)[_i]), (PG8_LAS unsigned*)(lds + (bufoff) + ldsw + _i * 8192), 16, 0, 0); } while (0)
#define PG8_LDA(dst, b, h) do { _Pragma("unroll") for (int m = 0; m < 4; ++m) _Pragma("unroll") for (int k = 0; k < 2; ++k) dst[m][k] = *(const PG8_LAS bf16x8*)(lds + PG8_SA(b, h) + aoff + m * 2048 + k * 1024); } while (0)
#define PG8_LDB(dst, b, h) do { _Pragma("unroll") for (int n = 0; n < 2; ++n) _Pragma("unroll") for (int k = 0; k < 2; ++k) dst[n][k] = *(const PG8_LAS bf16x8*)(lds + PG8_SB(b, h) + boff + n * 2048 + k * 1024); } while (0)
#define PG8_MMA(ai, bj, At, Bt) do { __builtin_amdgcn_s_setprio(1); _Pragma("unroll") for (int m = 0; m < 4; ++m) _Pragma("unroll") for (int n = 0; n < 2; ++n) _Pragma("unroll") for (int k = 0; k < 2; ++k) \
        acc[ai][bj][m][n] = __builtin_amdgcn_mfma_f32_16x16x32_bf16(Bt[n][k], At[m][k], acc[ai][bj][m][n], 0, 0, 0); __builtin_amdgcn_s_setprio(0); } while (0)
#define PG8_WAIT_V(n) asm volatile("s_waitcnt vmcnt(" #n ")" ::: "memory")
#define PG8_WAIT_L(n) asm volatile("s_waitcnt lgkmcnt(" #n ")" ::: "memory")
#define PG8_BAR __builtin_amdgcn_s_barrier()
#define PG8_SCHED __builtin_amdgcn_sched_barrier(0)
    Unit cur, nxt; int ui = 0;
    if (!S.next(0, cur)) return;
    f32x4 acc[2][2][4][2];
#pragma unroll
    for (int a = 0; a < 2; ++a)
#pragma unroll
        for (int b = 0; b < 2; ++b)
#pragma unroll
            for (int m = 0; m < 4; ++m)
#pragma unroll
                for (int n = 0; n < 2; ++n) acc[a][b][m][n] = (f32x4){0.f, 0.f, 0.f, 0.f};
    bf16x8 At[4][2], B0[2][2], B1[2][2];
    const char* cA = (const char*)g.A + (size_t)cur.pm * tstep; const char* cB = (const char*)g.Bt + (size_t)cur.pn * tstep;
    S.a_ready(cur);
    if constexpr (SP2) {
        PG8_STAGE(PG8_SB(0, 0), cB, voffB); PG8_STAGE(PG8_SB(0, 1), cB + hstep, voffB); PG8_STAGE(PG8_SA(0, 0), cA, voffA); PG8_STAGE(PG8_SA(0, 1), cA + hstep, voffA);
        if (wr == 1) PG8_BAR;
        PG8_WAIT_V(2); PG8_BAR;
        PG8_STAGE(PG8_SB(1, 0), cB + kstep, voffB); PG8_STAGE(PG8_SA(1, 0), cA + kstep, voffA); PG8_STAGE(PG8_SB(1, 1), cB + hstep + kstep, voffB);
        PG8_WAIT_V(6); PG8_BAR;
    } else {
        PG8_STAGE(PG8_SB(0, 0), cB, voffB); PG8_STAGE(PG8_SA(0, 0), cA, voffA); PG8_STAGE(PG8_SB(0, 1), cB + hstep, voffB); PG8_STAGE(PG8_SA(0, 1), cA + hstep, voffA);
        if (wr == 1) PG8_BAR;
        PG8_WAIT_V(4); PG8_BAR;
        PG8_STAGE(PG8_SB(1, 0), cB + kstep, voffB); PG8_STAGE(PG8_SA(1, 0), cA + kstep, voffA); PG8_STAGE(PG8_SB(1, 1), cB + hstep + kstep, voffB);
        PG8_WAIT_V(6); PG8_BAR;
    }
    for (;;) {
        const bool has_next = S.next(ui + 1, nxt);
        const char* nA = has_next ? (const char*)g.A + (size_t)nxt.pm * tstep : cA; const char* nB = has_next ? (const char*)g.Bt + (size_t)nxt.pn * tstep : cB;
        for (int t = 0; t < nt; t += 2) {
            const bool last = (t == nt - 2);
            const char* a1 = cA + (size_t)(t + 1) * kstep;
            const char* a2 = last ? nA : cA + (size_t)(t + 2) * kstep; const char* b2 = last ? nB : cB + (size_t)(t + 2) * kstep;
            const char* a3 = a2 + kstep; const char* b3 = b2 + kstep;
            if (last && has_next) S.a_ready(nxt);
            if constexpr (Epi::MID_T >= 0) { if (t == Epi::MID_T) E.mid(acc, cur, wr, fr); }
            if constexpr (SP2) {
            PG8_LDB(B0, 0, 0); PG8_LDB(B1, 0, 1); PG8_SCHED; PG8_LDA(At, 0, 0); PG8_STAGE(PG8_SA(1, 1), a1 + hstep, voffA);
            PG8_WAIT_V(8); PG8_WAIT_L(0); PG8_BAR; PG8_MMA(0, 0, At, B0); PG8_MMA(0, 1, At, B1); PG8_BAR; PG8_SCHED;
            PG8_LDA(At, 0, 1); PG8_STAGE(PG8_SB(0, 0), b2, voffB); PG8_STAGE(PG8_SB(0, 1), b2 + hstep, voffB); PG8_STAGE(PG8_SA(0, 0), a2, voffA);
            PG8_WAIT_V(8); PG8_WAIT_L(0); PG8_BAR; PG8_MMA(1, 0, At, B0); PG8_MMA(1, 1, At, B1); PG8_BAR; PG8_SCHED;
            PG8_LDB(B0, 1, 0); PG8_LDB(B1, 1, 1); PG8_SCHED; PG8_LDA(At, 1, 0); PG8_STAGE(PG8_SA(0, 1), a2 + hstep, voffA);
            PG8_WAIT_V(8); PG8_WAIT_L(0); PG8_BAR; PG8_MMA(0, 0, At, B0); PG8_MMA(0, 1, At, B1); PG8_BAR; PG8_SCHED;
            PG8_LDA(At, 1, 1); PG8_STAGE(PG8_SB(1, 0), b3, voffB); PG8_STAGE(PG8_SB(1, 1), b3 + hstep, voffB); PG8_STAGE(PG8_SA(1, 0), a3, voffA);
            PG8_WAIT_V(8); PG8_WAIT_L(0); PG8_BAR; PG8_MMA(1, 0, At, B0); PG8_MMA(1, 1, At, B1); PG8_BAR; PG8_SCHED;
            } else {
            PG8_LDB(B0, 0, 0); PG8_SCHED; PG8_LDA(At, 0, 0); PG8_STAGE(PG8_SA(1, 1), a1 + hstep, voffA);
            PG8_WAIT_L(8); PG8_BAR; PG8_WAIT_L(0); PG8_MMA(0, 0, At, B0); PG8_BAR; PG8_SCHED;
            PG8_LDB(B1, 0, 1); PG8_STAGE(PG8_SB(0, 0), b2, voffB);
            PG8_BAR; PG8_WAIT_L(0); PG8_MMA(0, 1, At, B1); PG8_BAR;
            PG8_LDA(At, 0, 1); PG8_STAGE(PG8_SA(0, 0), a2, voffA);
            PG8_BAR; PG8_WAIT_L(0); PG8_MMA(1, 0, At, B0); PG8_BAR; PG8_SCHED;
            PG8_STAGE(PG8_SB(0, 1), b2 + hstep, voffB);
            PG8_WAIT_V(6); PG8_BAR; PG8_MMA(1, 1, At, B1); PG8_BAR;
            PG8_LDB(B0, 1, 0); PG8_SCHED; PG8_LDA(At, 1, 0); PG8_STAGE(PG8_SA(0, 1), a2 + hstep, voffA);
            PG8_WAIT_L(8); PG8_BAR; PG8_WAIT_L(0); PG8_MMA(0, 0, At, B0); PG8_BAR; PG8_SCHED;
            PG8_LDB(B1, 1, 1); PG8_STAGE(PG8_SB(1, 0), b3, voffB);
            PG8_BAR; PG8_WAIT_L(0); PG8_MMA(0, 1, At, B1); PG8_BAR;
            PG8_LDA(At, 1, 1); PG8_STAGE(PG8_SA(1, 0), a3, voffA);
            PG8_BAR; PG8_WAIT_L(0); PG8_MMA(1, 0, At, B0); PG8_BAR; PG8_SCHED;
            PG8_STAGE(PG8_SB(1, 1), b3 + hstep, voffB);
            PG8_WAIT_V(6); PG8_BAR; PG8_MMA(1, 1, At, B1); PG8_BAR;
            }
        }
        if constexpr (ALIGN_EPI) { if (wr == 0) PG8_BAR; }
        if constexpr (!Epi::AFTER_DRAIN) { E(acc, cur, wr, wc, fr, fq); S.done(cur); }
        if (!has_next) break;
#pragma unroll
        for (int a = 0; a < 2; ++a)
#pragma unroll
            for (int b = 0; b < 2; ++b)
#pragma unroll
                for (int m = 0; m < 4; ++m)
#pragma unroll
                    for (int n = 0; n < 2; ++n) acc[a][b][m][n] = (f32x4){0.f, 0.f, 0.f, 0.f};
        cur = nxt; cA = nA; cB = nB; ++ui;
        if constexpr (ALIGN_EPI) { if (wr == 1) PG8_BAR; }
    }
    PG8_WAIT_V(0);
    if constexpr (!ALIGN_EPI) { if (wr == 0) PG8_BAR; }
    PG8_BAR;
    if constexpr (Epi::AFTER_DRAIN) { E.fused(acc, cur, wr, wc, fr, fq, lds, wid, lane); S.done(cur); }
#undef PG8_SA
#undef PG8_SB
#undef PG8_STAGE
#undef PG8_LDA
#undef PG8_LDB
#undef PG8_MMA
#undef PG8_WAIT_V
#undef PG8_WAIT_L
#undef PG8_BAR
#undef PG8_SCHED
}
}
constexpr int NWAVES = 8, NTHR = 512;
constexpr int MTOK = 16384, DMOD = 1024, NPJ = 3072, NPROJ = 3088, DFF = 2816, NUP = 5632;
constexpr float EPS = 1e-6f;
constexpr size_t MiB = 1u << 20;
constexpr size_t WS_CTL = 0, CTL_ZERO_BYTES = 1 * MiB;
constexpr size_t WS_DT = 1 * MiB;
constexpr size_t WS_WIN = 2 * MiB, WS_WOUT = 8 * MiB, WS_WUP = 10 * MiB, WS_WDN = 21 * MiB;
constexpr size_t WS_AX = 32 * MiB;
constexpr size_t WS_PROJ = 64 * MiB;
constexpr size_t WS_A3 = 160 * MiB;
constexpr size_t WS_YF = 192 * MiB;
constexpr size_t WS_G = 64 * MiB;
constexpr size_t WS_U = 160 * MiB;
constexpr size_t WS_END = 256 * MiB;
static_assert(WS_WDN + (size_t)1024 * 2816 * 2 <= WS_AX && WS_G + (size_t)16384 * 2816 * 2 <= WS_U && WS_U + (size_t)8192 * 5632 * 2 <= WS_END, "ws map");
constexpr int CW_TMO = 0, CW_BAR = 4096, CW_MOD = 16384, CW_SSQY = 73728, CW_SSQ2 = 90112, CW_SSQ3 = 106496, CW_SV2 = 122880;
static_assert(CW_SV2 + 9 * 5632 <= (int)(CTL_ZERO_BYTES / 4), "ctl");
constexpr int LDS_SCRATCH = 153600, LDSCTL_OFF = LDS_SCRATCH, LDS_BYTES = 155648;

#define GAS __attribute__((address_space(1)))
#define LAS __attribute__((address_space(3)))
typedef unsigned short bf16;
typedef unsigned v4u __attribute__((ext_vector_type(4)));
typedef unsigned v2u __attribute__((ext_vector_type(2)));
typedef float f32x4 __attribute__((ext_vector_type(4)));
typedef float f32x16 __attribute__((ext_vector_type(16)));
typedef short bf16x8 __attribute__((ext_vector_type(8)));
typedef short s16x4 __attribute__((ext_vector_type(4)));
typedef float f32x2_t __attribute__((ext_vector_type(2)));
typedef __bf16 bf16x2_t __attribute__((ext_vector_type(2)));
#define LDS_WAIT() asm volatile("s_waitcnt lgkmcnt(0)" ::: "memory")
#define VM_WAIT() asm volatile("s_waitcnt vmcnt(0)" ::: "memory")
__device__ __forceinline__ unsigned pk2(float lo, float hi) { f32x2_t v = {lo, hi}; bf16x2_t b = __builtin_convertvector(v, bf16x2_t); return __builtin_bit_cast(unsigned, b); }
__device__ __forceinline__ float bflo(unsigned u) { return __uint_as_float(u << 16); }
__device__ __forceinline__ float bfhi(unsigned u) { return __uint_as_float(u & 0xffff0000u); }
__device__ __forceinline__ float silu_f(float x) { return x * __builtin_amdgcn_rcpf(1.f + __expf(-x)); }
__device__ __forceinline__ float softplus_f(float x) { return fmaxf(x, 0.f) + log1pf(__expf(-fabsf(x))); }
__device__ __forceinline__ float wave_sum(float v) {
#pragma unroll
    for (int o = 1; o < 64; o <<= 1) v += __shfl_xor(v, o);
    return v;
}

#define XB_TMO      128
#define XB_XCNT(j)  (256  + 64 * (j))
#define XB_XSUB(j)  (1280 + 64 * (j))
#define XB_XGEN(j)  (2304 + 64 * (j))
#define XB_TOP      3328
#define XB_TOPGEN   3392
#define XCD_BAR_WORDS 3456
#define XB_SPIN_CAP (1u << 18)
__device__ __forceinline__ unsigned xb_ld(unsigned* p)              { return __hip_atomic_load(p, __ATOMIC_RELAXED, __HIP_MEMORY_SCOPE_AGENT); }
__device__ __forceinline__ unsigned xb_add(unsigned* p, unsigned v) { return __hip_atomic_fetch_add(p, v, __ATOMIC_RELAXED, __HIP_MEMORY_SCOPE_AGENT); }
__device__ __forceinline__ unsigned xb_xcc_id() { return (unsigned)__builtin_amdgcn_s_getreg((3 << 11) | 20) & 0xFu; }
#define XB_SPIN(cond, bar) do { unsigned _sp = 0; while (cond) { __builtin_amdgcn_s_sleep(1); \
    if ((++_sp & 255u) == 0u) { if (xb_ld(&(bar)[XB_TMO])) break; if (_sp > XB_SPIN_CAP) { atomicAdd(&(bar)[XB_TMO], 1u); break; } } } } while (0)
struct XcdBarrier { unsigned* bar; unsigned x; volatile LAS unsigned* st; };
__device__ __forceinline__ XcdBarrier xcd_barrier_post(unsigned* bar, volatile LAS unsigned* st) {
    XcdBarrier b; b.bar = bar; b.x = xb_xcc_id(); b.st = st;
    if (threadIdx.x == 0) (void)xb_add(&bar[XB_XCNT(b.x)], 1u);
    return b;
}
__device__ __forceinline__ void xcd_barrier_complete(unsigned* bar, unsigned x, unsigned& nloc, unsigned& nx) {
    const unsigned G = gridDim.x * gridDim.y * gridDim.z;
    unsigned sum, cnt, mine, sp = 0u;
    for (;;) {
        sum = 0u; cnt = 0u; mine = 0u;
#pragma unroll
        for (unsigned j = 0; j < 16; ++j) { const unsigned c = xb_ld(&bar[XB_XCNT(j)]); sum += c; cnt += (c > 0u) ? 1u : 0u; mine = (j == x) ? c : mine; }
        if (sum == G) break;
        __builtin_amdgcn_s_sleep(1);
        if ((++sp & 255u) == 0u) { if (xb_ld(&bar[XB_TMO])) break; if (sp > XB_SPIN_CAP) { atomicAdd(&bar[XB_TMO], 1u); break; } }
    }
    nloc = mine > 0u ? mine : 1u; nx = cnt > 0u ? cnt : 1u;
}
__device__ __forceinline__ void xcd_barrier(const XcdBarrier& b) {
    asm volatile("s_waitcnt vmcnt(0)" ::: "memory");
    __syncthreads();
    if (threadIdx.x == 0) {
        unsigned* bar = b.bar;
        __builtin_amdgcn_s_waitcnt(0);
        unsigned nloc = b.st[0], nx = b.st[1];
        if (nloc == 0u) { xcd_barrier_complete(bar, b.x, nloc, nx); b.st[0] = nloc; b.st[1] = nx; }
        const unsigned old = xb_add(&bar[XB_XSUB(b.x)], 1u);
        const unsigned gen = old / nloc;
        if (old + 1u == (gen + 1u) * nloc) {
            __builtin_amdgcn_fence(__ATOMIC_RELEASE, "agent");
            asm volatile("s_waitcnt vmcnt(0)" ::: "memory");
            const unsigned og = xb_add(&bar[XB_TOP], 1u);
            const unsigned tg = og / nx;
            if (og + 1u == (tg + 1u) * nx) xb_add(&bar[XB_TOPGEN], 1u);
            else XB_SPIN(xb_ld(&bar[XB_TOPGEN]) == tg, bar);
            __builtin_amdgcn_fence(__ATOMIC_ACQUIRE, "agent");
            xb_add(&bar[XB_XGEN(b.x)], 1u);
            asm volatile("s_waitcnt vmcnt(0)" ::: "memory");
        } else {
            XB_SPIN(xb_ld(&bar[XB_XGEN(b.x)]) == gen, bar);
            __builtin_amdgcn_fence(__ATOMIC_ACQUIRE, "agent");
            asm volatile("s_waitcnt vmcnt(0)" ::: "memory");
        }
    }
    __syncthreads();
}

struct Args { const float* in[24]; float* out; unsigned char* ws; };
__device__ __forceinline__ int opaque_i(int x) { asm volatile("" : "+v"(x)); return x; }

__device__ __forceinline__ void transpose_item(const float* W, int ldw, int ks0, int n0, bf16* WT, int K, int kd0, LAS float* scr, int lane) {
#pragma unroll 8
    for (int i = 0; i < 32; ++i) { const int kk = 2 * i + (lane >> 5); scr[kk * 33 + (lane & 31)] = W[(size_t)(ks0 + kk) * ldw + n0 + (lane & 31)]; }
    LDS_WAIT(); asm volatile("" ::: "memory");
    const int c = lane & 7;
#pragma unroll
    for (int j = 0; j < 4; ++j) { const int n = (lane >> 3) + 8 * j; const LAS float* s = scr + (8 * c) * 33 + n;
        v4u o; o.x = pk2(s[0 * 33], s[1 * 33]); o.y = pk2(s[2 * 33], s[3 * 33]); o.z = pk2(s[4 * 33], s[5 * 33]); o.w = pk2(s[6 * 33], s[7 * 33]);
        *(GAS v4u*)(WT + (size_t)(n0 + n) * K + kd0 + 8 * c) = o; }
    LDS_WAIT(); asm volatile("" ::: "memory");
}

__device__ __forceinline__ void phase0(const Args& a, LAS unsigned char* lds, int tid, int lane, int wave, int vcu, int G) {
    const float *c = a.in[4], *c_ctx = a.in[5], *w_ada = a.in[8];
    float* modz = (float*)(a.ws + WS_CTL) + CW_MOD;
    LAS float* sc = (LAS float*)lds;
    for (int i = tid; i < 9 * 1024; i += NTHR) { const int mb = i >> 10, k = i & 1023; const float v = mb == 0 ? c_ctx[k] : c[(mb - 1) * 1024 + k]; sc[i] = silu_f(v); }
    __syncthreads();
    for (int it = blockIdx.x; it < 192; it += G) {
        const int cb = it % 12, kc = it / 12, col = cb * 512 + tid;
        float acc[9];
#pragma unroll
        for (int mb = 0; mb < 9; ++mb) acc[mb] = 0.f;
#pragma unroll 8
        for (int kk = 0; kk < 64; ++kk) { const int k = kc * 64 + kk; const float w = w_ada[(size_t)k * 6144 + col];
#pragma unroll
            for (int mb = 0; mb < 9; ++mb) acc[mb] += sc[mb * 1024 + k] * w; }
#pragma unroll
        for (int mb = 0; mb < 9; ++mb) atomicAdd(modz + mb * 6144 + col, acc[mb]);
    }
    LAS float* scr = (LAS float*)(lds + 40960 + wave * 8448);
    const int gw = vcu * NWAVES + wave, NGW = G * NWAVES;
    constexpr int I_IN = 16 * 96, I_OUT = 16 * 32, I_UP = 16 * 176, I_DN = 44 * 32, NITEMS = I_IN + I_OUT + I_UP + I_DN;
    bf16 *WinT = (bf16*)(a.ws + WS_WIN), *WoutT = (bf16*)(a.ws + WS_WOUT), *WupT = (bf16*)(a.ws + WS_WUP), *WdnT = (bf16*)(a.ws + WS_WDN);
    for (int it = gw; it < NITEMS; it += NGW) {
        int r = it;
        if (r < I_IN) { const int kb = r / 96, nb = r % 96; transpose_item(a.in[10], NPROJ, kb * 64, nb * 32, WinT, 1024, kb * 64, scr, lane); continue; } r -= I_IN;
        if (r < I_OUT) { const int kb = r / 32, nb = r % 32; transpose_item(a.in[18], 1024, (kb * 64 + 512) & 1023, nb * 32, WoutT, 1024, kb * 64, scr, lane); continue; } r -= I_OUT;
        if (r < I_UP) { const int kb = r / 176, nb = r % 176; transpose_item(a.in[19], NUP, kb * 64, nb * 32, WupT, 1024, kb * 64, scr, lane); continue; } r -= I_UP;
        { const int kb = r / 32, nb = r % 32; transpose_item(a.in[22], 1024, kb * 64, nb * 32, WdnT, DFF, kb * 64, scr, lane); }
    }
}

__device__ __forceinline__ void phase1(const Args& a, LAS unsigned char* lds, int tid, int lane, int wave, int vcu, int G) {
    const float* modz = (const float*)(a.ws + WS_CTL) + CW_MOD; const float* b_ada = a.in[9];
    float* sv2 = (float*)(a.ws + WS_CTL) + CW_SV2;
    {
        LAS float* shf = (LAS float*)(lds + 65536);
        const float* w_up = a.in[19];
        for (int it = blockIdx.x; it < 176; it += G) {
            const int cb = it % 11, kc = it / 11, col = cb * 512 + tid;
            __syncthreads();
            for (int i = tid; i < 9 * 64; i += NTHR) { const int mb = i >> 6, kk = i & 63; shf[i] = modz[mb * 6144 + 3 * 1024 + kc * 64 + kk] + b_ada[3 * 1024 + kc * 64 + kk]; }
            __syncthreads();
            float acc[9];
#pragma unroll
            for (int mb = 0; mb < 9; ++mb) acc[mb] = 0.f;
#pragma unroll 8
            for (int kk = 0; kk < 64; ++kk) { const float w = w_up[(size_t)(kc * 64 + kk) * NUP + col];
#pragma unroll
                for (int mb = 0; mb < 9; ++mb) acc[mb] += shf[mb * 64 + kk] * w; }
#pragma unroll
            for (int mb = 0; mb < 9; ++mb) atomicAdd(sv2 + mb * 5632 + col, acc[mb]);
        }
    }
    LAS float* wdt = (LAS float*)lds;
    { const float* w_in = a.in[10];
      for (int i = tid; i < 16384; i += NTHR) { const int cc = i >> 4, j = i & 15; wdt[j * 1024 + cc] = w_in[(size_t)cc * NPROJ + NPJ + j]; } }
    __syncthreads();
    const float* g1 = a.in[6]; const float* dt_bias = a.in[14];
    bf16* A1 = (bf16*)(a.ws + WS_AX); float* DT = (float*)(a.ws + WS_DT);
    const int gw = vcu * NWAVES + wave, NGW = G * NWAVES;
    for (int rb = gw; rb < MTOK / 8; rb += NGW) {
        const int row0 = rb * 8, mb = pg8::mb_of_tile(row0 >> 8);
        f32x4 gs[4], sh[4];
#pragma unroll
        for (int jj = 0; jj < 4; ++jj) { const int cc = 4 * lane + 256 * jj;
            gs[jj] = *(const f32x4*)(g1 + cc) * (*(const f32x4*)(modz + mb * 6144 + 1024 + cc) + *(const f32x4*)(b_ada + 1024 + cc) + 1.0f);
            sh[jj] = *(const f32x4*)(modz + mb * 6144 + cc) + *(const f32x4*)(b_ada + cc); }
        for (int rr = 0; rr < 8; ++rr) {
            const int row = row0 + rr;
            asm volatile("" ::: "memory");
            const float* xr = row < 8192 ? a.in[0] + (size_t)row * 1024 : a.in[1] + (size_t)(row - 8192) * 1024;
            f32x4 v[4]; float s = 0.f;
#pragma unroll
            for (int jj = 0; jj < 4; ++jj) { v[jj] = *(const f32x4*)(xr + 4 * lane + 256 * jj); s += (v[jj][0] * v[jj][0] + v[jj][1] * v[jj][1]) + (v[jj][2] * v[jj][2] + v[jj][3] * v[jj][3]); }
            const float r = __builtin_amdgcn_rsqf(wave_sum(s) * (1.0f / 1024.0f) + EPS);
#pragma unroll
            for (int jj = 0; jj < 4; ++jj) { v[jj] = (v[jj] * r) * gs[jj] + sh[jj];
                v2u o; o.x = pk2(v[jj][0], v[jj][1]); o.y = pk2(v[jj][2], v[jj][3]);
                *(GAS v2u*)(A1 + (size_t)row * 1024 + 4 * lane + 256 * jj) = o; }
            float mydt = 0.f;
#pragma unroll
            for (int j = 0; j < 16; ++j) { float p = 0.f;
#pragma unroll
                for (int jj = 0; jj < 4; ++jj) { const f32x4 w = *(const LAS f32x4*)(wdt + j * 1024 + 4 * lane + 256 * jj); p += (v[jj][0] * w[0] + v[jj][1] * w[1]) + (v[jj][2] * w[2] + v[jj][3] * w[3]); }
                p = wave_sum(p); if (lane == j) mydt = p; }
            if (lane < 16) DT[(size_t)row * 16 + lane] = softplus_f(mydt + dt_bias[lane]);
        }
    }
}

__device__ __forceinline__ void phase_xc(const Args& a, int lane, int gw, int NGW) {
    const bf16* PROJ = (const bf16*)(a.ws + WS_PROJ); bf16* XC = (bf16*)(a.ws + WS_AX); bf16* A3 = (bf16*)(a.ws + WS_A3);
    const float *w_cs = a.in[11], *w_cssd = a.in[12], *b_cssd = a.in[13];
    const v4u z4 = {0u, 0u, 0u, 0u};
    for (int id = gw; id < 2048 * 3; id += NGW) {
        const int run = id / 3, kind = id - run * 3, row0 = run * 8;
        const bool samp = row0 >= 8192; const int L = samp ? 1024 : 256, t0 = samp ? ((row0 - 8192) & 1023) : (row0 & 255);
        const bool has_prev = t0 > 0, has_next = t0 + 8 < L;
        if (kind < 2) {
            const int ch0 = kind * 512 + lane * 8; const bf16* src = PROJ + (size_t)row0 * NPJ + 2048 + ch0;
            v4u x[10];
            x[0] = has_prev ? *(const GAS v4u*)(src - NPJ) : z4;
#pragma unroll
            for (int rr = 0; rr < 8; ++rr) x[rr + 1] = *(const GAS v4u*)(src + (size_t)rr * NPJ);
            x[9] = has_next ? *(const GAS v4u*)(src + (size_t)8 * NPJ) : z4;
            float w[3][8], b[8];
#pragma unroll
            for (int k = 0; k < 3; ++k) { const f32x4 w0 = *(const f32x4*)(w_cssd + k * 1024 + ch0), w1 = *(const f32x4*)(w_cssd + k * 1024 + ch0 + 4);
                w[k][0] = w0[0]; w[k][1] = w0[1]; w[k][2] = w0[2]; w[k][3] = w0[3]; w[k][4] = w1[0]; w[k][5] = w1[1]; w[k][6] = w1[2]; w[k][7] = w1[3]; }
            { const f32x4 b0 = *(const f32x4*)(b_cssd + ch0), b1 = *(const f32x4*)(b_cssd + ch0 + 4); b[0] = b0[0]; b[1] = b0[1]; b[2] = b0[2]; b[3] = b0[3]; b[4] = b1[0]; b[5] = b1[1]; b[6] = b1[2]; b[7] = b1[3]; }
#pragma unroll
            for (int rr = 0; rr < 8; ++rr) { v4u o;
#pragma unroll
                for (int e2 = 0; e2 < 4; ++e2) {
                    const float lo = b[2 * e2] + w[0][2 * e2] * bflo(x[rr][e2]) + w[1][2 * e2] * bflo(x[rr + 1][e2]) + w[2][2 * e2] * bflo(x[rr + 2][e2]);
                    const float hi = b[2 * e2 + 1] + w[0][2 * e2 + 1] * bfhi(x[rr][e2]) + w[1][2 * e2 + 1] * bfhi(x[rr + 1][e2]) + w[2][2 * e2 + 1] * bfhi(x[rr + 2][e2]);
                    o[e2] = pk2(silu_f(lo), silu_f(hi)); }
                *(GAS v4u*)(XC + (size_t)(row0 + rr) * 1024 + ch0) = o; }
        } else {
            const int c0 = lane * 8; const bf16* src = PROJ + (size_t)row0 * NPJ + c0;
            v4u hc[10], gc[10], gb[8];
            hc[0] = has_prev ? *(const GAS v4u*)(src - NPJ) : z4; gc[0] = has_prev ? *(const GAS v4u*)(src - NPJ + 1024) : z4;
#pragma unroll
            for (int rr = 0; rr < 8; ++rr) { hc[rr + 1] = *(const GAS v4u*)(src + (size_t)rr * NPJ); gc[rr + 1] = *(const GAS v4u*)(src + (size_t)rr * NPJ + 1024); gb[rr] = *(const GAS v4u*)(src + (size_t)rr * NPJ + 512); }
            hc[9] = has_next ? *(const GAS v4u*)(src + (size_t)8 * NPJ) : z4; gc[9] = has_next ? *(const GAS v4u*)(src + (size_t)8 * NPJ + 1024) : z4;
            float w[3][8];
#pragma unroll
            for (int k = 0; k < 3; ++k) { const f32x4 w0 = *(const f32x4*)(w_cs + k * 512 + c0), w1 = *(const f32x4*)(w_cs + k * 512 + c0 + 4);
                w[k][0] = w0[0]; w[k][1] = w0[1]; w[k][2] = w0[2]; w[k][3] = w0[3]; w[k][4] = w1[0]; w[k][5] = w1[1]; w[k][6] = w1[2]; w[k][7] = w1[3]; }
#pragma unroll
            for (int rr = 0; rr < 8; ++rr) { v4u o;
#pragma unroll
                for (int e2 = 0; e2 < 4; ++e2) {
                    const float lo = w[0][2 * e2] * (bflo(hc[rr][e2]) * bflo(gc[rr][e2])) + w[1][2 * e2] * (bflo(hc[rr + 1][e2]) * bflo(gc[rr + 1][e2])) + w[2][2 * e2] * (bflo(hc[rr + 2][e2]) * bflo(gc[rr + 2][e2]));
                    const float hi = w[0][2 * e2 + 1] * (bfhi(hc[rr][e2]) * bfhi(gc[rr][e2])) + w[1][2 * e2 + 1] * (bfhi(hc[rr + 1][e2]) * bfhi(gc[rr + 1][e2])) + w[2][2 * e2 + 1] * (bfhi(hc[rr + 2][e2]) * bfhi(gc[rr + 2][e2]));
                    o[e2] = pk2(lo * bflo(gb[rr][e2]), hi * bfhi(gb[rr][e2])); }
                *(GAS v4u*)(A3 + (size_t)(row0 + rr) * 1024 + 512 + c0) = o; }
        }
    }
}

constexpr int O_IB = 0, O_IC = 32768, O_IX = 65536, O_SB = 81920, O_CS = 98304, O_DTV = 102400, O_WG = 106496;
#define MFMA32(a, b, c) __builtin_amdgcn_mfma_f32_32x32x16_bf16((a), (b), (c), 0, 0, 0)
typedef short v4i16_t __attribute__((ext_vector_type(4)));
__device__ __forceinline__ int img_off(int row, int ch) { return row * 256 + ((ch ^ (row & 15)) << 4); }
__device__ __forceinline__ s16x4 lds_tr(LAS unsigned char* p) { return __builtin_bit_cast(s16x4, __builtin_amdgcn_ds_read_tr16_b64_v4i16((LAS v4i16_t*)p)); }
__device__ __forceinline__ s16x4 tr4(LAS unsigned char* img, bool swz, int r0, int c0, int lane) {
    const int blk = (lane >> 4) & 1, q = (lane & 15) >> 2, p = lane & 3, row = r0 + q, ch = (c0 >> 3) + 2 * blk + (p >> 1);
    return lds_tr(img + (swz ? img_off(row, ch) : row * 128 + (ch << 4)) + 8 * (p & 1));
}
__device__ __forceinline__ void ssd_stage_c(LAS unsigned char* lds, const bf16* XC, int row_base, int L, int dir, int k, int g, int lane, int wave) {
#pragma unroll
    for (int i = 0; i < 4; ++i) { const int piece = wave * 4 + i, r = piece * 4 + (lane >> 4), s = lane & 15, c = s ^ (r & 15);
        const int j = k * 128 + r, t = dir ? L - 1 - j : j; const bf16* src = XC + (size_t)(row_base + t) * 1024 + 768 + g * 128 + c * 8;
        __builtin_amdgcn_global_load_lds((const unsigned*)src, (LAS unsigned*)(lds + O_IC + piece * 1024), 16, 0, 0); }
}
__device__ __forceinline__ void ssd_stage_bx(LAS unsigned char* lds, const bf16* XC, int row_base, int L, int dir, int k, int h, int g, int lane, int wave) {
#pragma unroll
    for (int i = 0; i < 4; ++i) { const int piece = wave * 4 + i, r = piece * 4 + (lane >> 4), s = lane & 15, c = s ^ (r & 15);
        const int j = k * 128 + r, t = dir ? L - 1 - j : j; const bf16* src = XC + (size_t)(row_base + t) * 1024 + 512 + g * 128 + c * 8;
        __builtin_amdgcn_global_load_lds((const unsigned*)src, (LAS unsigned*)(lds + O_IB + piece * 1024), 16, 0, 0); }
#pragma unroll
    for (int i = 0; i < 2; ++i) { const int piece = wave * 2 + i, r = piece * 8 + (lane >> 3), c = lane & 7;
        const int j = k * 128 + r, t = dir ? L - 1 - j : j; const bf16* src = XC + (size_t)(row_base + t) * 1024 + h * 64 + c * 8;
        __builtin_amdgcn_global_load_lds((const unsigned*)src, (LAS unsigned*)(lds + O_IX + piece * 1024), 16, 0, 0); }
}

__device__ __forceinline__ void ssd_unit(const Args& a, LAS unsigned char* lds, int tid, int lane, int wave, int seq, int h, int dir) {
    const bool samp = seq >= 32;
    const int L = samp ? 1024 : 256, nc = L >> 7, row_base = samp ? 8192 + (seq - 32) * 1024 : seq * 256, g = h >> 2;
    const bf16* XC = (const bf16*)(a.ws + WS_AX);
    const float* DT = (const float*)(a.ws + WS_DT);
    bf16* YD = (bf16*)(a.ws + WS_YF) + (size_t)dir * MTOK * 512;
    const float dskip = a.in[16][h];
    const int hh = lane >> 5, l31 = lane & 31;
    const int jt = wave >> 1, q = wave & 1;
    const float aA = -__expf(a.in[15][dir * 8 + h]);
    f32x16 St;
    if (samp) { const float* init = a.in[2 + dir] + ((size_t)((seq - 32) * 8 + h) * 64 + 32 * q + l31) * 128 + 32 * jt;
#pragma unroll
        for (int gq = 0; gq < 4; ++gq) { const f32x4 v = *(const f32x4*)(init + 8 * gq + 4 * hh); St[4 * gq] = v[0]; St[4 * gq + 1] = v[1]; St[4 * gq + 2] = v[2]; St[4 * gq + 3] = v[3]; }
    } else {
#pragma unroll
        for (int i = 0; i < 16; ++i) St[i] = 0.f;
    }
    VM_WAIT();
    __syncthreads();
    if (wave < nc) {
        LAS float* CS = (LAS float*)(lds + O_CS) + wave * 128; LAS float* DTV = (LAS float*)(lds + O_DTV) + wave * 128; LAS float* WG = (LAS float*)(lds + O_WG) + wave * 128;
        const int j0 = wave * 128 + 2 * lane, t0 = dir ? L - 1 - j0 : j0, t1 = dir ? t0 - 1 : t0 + 1;
        const float d0 = DT[(size_t)(row_base + t0) * 16 + dir * 8 + h], d1 = DT[(size_t)(row_base + t1) * 16 + dir * 8 + h];
        const float a0 = d0 * aA, a1 = d1 * aA, s = a0 + a1;
        float incl = s;
#pragma unroll
        for (int o = 1; o < 64; o <<= 1) { const float v = __shfl_up(incl, o); if (lane >= o) incl += v; }
        const float excl = incl - s, c0 = excl + a0, c1 = excl + s, cend = __shfl(incl, 63);
        CS[2 * lane] = c0; CS[2 * lane + 1] = c1; DTV[2 * lane] = d0; DTV[2 * lane + 1] = d1;
        WG[2 * lane] = d0 * __expf(cend - c0); WG[2 * lane + 1] = d1 * __expf(cend - c1);
    }
    ssd_stage_c(lds, XC, row_base, L, dir, 0, g, lane, wave);
    ssd_stage_bx(lds, XC, row_base, L, dir, 0, h, g, lane, wave);
#pragma unroll
    for (int gq = 0; gq < 4; ++gq) { v2u o; o.x = pk2(St[4 * gq], St[4 * gq + 1]); o.y = pk2(St[4 * gq + 2], St[4 * gq + 3]);
        const int prow = 32 * q + l31, n0 = 32 * jt + 8 * gq + 4 * hh;
        *(LAS v2u*)(lds + O_SB + img_off(prow, n0 >> 3) + (n0 & 7) * 2) = o; }

    for (int k = 0; k < nc; ++k) {
        VM_WAIT();
        __syncthreads();
        int lz = lane; asm volatile("" : "+v"(lz)); const int hhz = lz >> 5, l31z = lz & 31;
        LAS float* CS = (LAS float*)(lds + O_CS) + k * 128; LAS float* DTV = (LAS float*)(lds + O_DTV) + k * 128; LAS float* WG = (LAS float*)(lds + O_WG) + k * 128;
        bf16x8 cf[8];
#pragma unroll
        for (int ks = 0; ks < 8; ++ks) cf[ks] = *(const LAS bf16x8*)(lds + O_IC + img_off(32 * jt + l31z, 2 * ks + hhz));
        f32x16 Y;
#pragma unroll
        for (int i = 0; i < 16; ++i) Y[i] = 0.f;
#pragma unroll
        for (int ks = 0; ks < 8; ++ks) { const bf16x8 sa = *(const LAS bf16x8*)(lds + O_SB + img_off(32 * q + l31z, 2 * ks + hhz)); Y = MFMA32(sa, cf[ks], Y); }
        if (k + 1 < nc) {
            asm volatile("s_waitcnt lgkmcnt(0)" ::: "memory"); __builtin_amdgcn_s_barrier(); asm volatile("" ::: "memory");
            ssd_stage_c(lds, XC, row_base, L, dir, k + 1, g, lz, wave);
        }
        const float csl = CS[32 * jt + l31z];
        { const float el_ = __expf(csl);
#pragma unroll
          for (int i = 0; i < 16; ++i) Y[i] *= el_; }
        for (int it = 0; it <= jt; ++it) {
            f32x16 Gt;
#pragma unroll
            for (int i = 0; i < 16; ++i) Gt[i] = 0.f;
#pragma unroll
            for (int ks = 0; ks < 8; ++ks) { const bf16x8 ba = *(const LAS bf16x8*)(lds + O_IB + img_off(32 * it + l31z, 2 * ks + hhz)); Gt = MFMA32(ba, cf[ks], Gt); }
            const bool dg = (it == jt);
#pragma unroll
            for (int gq = 0; gq < 4; ++gq) {
                const f32x4 cs4 = *(const LAS f32x4*)(CS + 32 * it + 8 * gq + 4 * hhz), dt4 = *(const LAS f32x4*)(DTV + 32 * it + 8 * gq + 4 * hhz);
#pragma unroll
                for (int e = 0; e < 4; ++e) { const int sl = 8 * gq + 4 * hhz + e;
                    float v = Gt[4 * gq + e] * dt4[e] * __expf(csl - cs4[e]);
                    if (dg) { if (sl > l31z) v = 0.f; if (dir == 0 && sl == l31z) v += dskip; }
                    Gt[4 * gq + e] = v; }
            }
#pragma unroll
            for (int st = 0; st < 2; ++st) {
                v4u pb; pb.x = pk2(Gt[8 * st], Gt[8 * st + 1]); pb.y = pk2(Gt[8 * st + 2], Gt[8 * st + 3]); pb.z = pk2(Gt[8 * st + 4], Gt[8 * st + 5]); pb.w = pk2(Gt[8 * st + 6], Gt[8 * st + 7]);
                const s16x4 xa0 = tr4(lds + O_IX, false, 32 * it + 16 * st + 4 * hhz, 32 * q, lz);
                const s16x4 xa1 = tr4(lds + O_IX, false, 32 * it + 16 * st + 8 + 4 * hhz, 32 * q, lz);
                const bf16x8 xa = __builtin_shufflevector(xa0, xa1, 0, 1, 2, 3, 4, 5, 6, 7);
                Y = MFMA32(xa, __builtin_bit_cast(bf16x8, pb), Y);
            }
        }
        { const float cd = __expf(CS[127]);
#pragma unroll
          for (int i = 0; i < 16; ++i) St[i] *= cd; }
#pragma unroll
        for (int ks = 0; ks < 8; ++ks) {
            const s16x4 wa0 = tr4(lds + O_IB, true, 16 * ks + 8 * hhz, 32 * jt, lz), wa1 = tr4(lds + O_IB, true, 16 * ks + 8 * hhz + 4, 32 * jt, lz);
            const s16x4 xb0 = tr4(lds + O_IX, false, 16 * ks + 8 * hhz, 32 * q, lz), xb1 = tr4(lds + O_IX, false, 16 * ks + 8 * hhz + 4, 32 * q, lz);
            const f32x4 w0 = *(const LAS f32x4*)(WG + 16 * ks + 8 * hhz), w1 = *(const LAS f32x4*)(WG + 16 * ks + 8 * hhz + 4);
            const v2u x0 = __builtin_bit_cast(v2u, xb0), x1 = __builtin_bit_cast(v2u, xb1);
            v4u xs; xs.x = pk2(bflo(x0.x) * w0[0], bfhi(x0.x) * w0[1]); xs.y = pk2(bflo(x0.y) * w0[2], bfhi(x0.y) * w0[3]);
            xs.z = pk2(bflo(x1.x) * w1[0], bfhi(x1.x) * w1[1]); xs.w = pk2(bflo(x1.y) * w1[2], bfhi(x1.y) * w1[3]);
            const bf16x8 wa = __builtin_shufflevector(wa0, wa1, 0, 1, 2, 3, 4, 5, 6, 7);
            St = MFMA32(wa, __builtin_bit_cast(bf16x8, xs), St);
        }
        asm volatile("s_waitcnt lgkmcnt(0)" ::: "memory"); __builtin_amdgcn_s_barrier(); asm volatile("" ::: "memory");
        int lq = lane; asm volatile("" : "+v"(lq)); const int hhq = lq >> 5, l31q = lq & 31;
        if (k + 1 < nc) ssd_stage_bx(lds, XC, row_base, L, dir, k + 1, h, g, lq, wave);
#pragma unroll
        for (int gq = 0; gq < 4; ++gq) { v2u o; o.x = pk2(St[4 * gq], St[4 * gq + 1]); o.y = pk2(St[4 * gq + 2], St[4 * gq + 3]);
            const int prow = 32 * q + l31q, n0 = 32 * jt + 8 * gq + 4 * hhq;
            *(LAS v2u*)(lds + O_SB + img_off(prow, n0 >> 3) + (n0 & 7) * 2) = o; }
        if (!samp && k == nc - 1) {
            float* so = a.out + (size_t)2 * 8192 * 1024 + (size_t)dir * 2097152 + ((size_t)(seq * 8 + h) * 64 + 32 * q + l31q) * 128 + 32 * jt;
#pragma unroll
            for (int gq = 0; gq < 4; ++gq) { f32x4 v = {St[4 * gq], St[4 * gq + 1], St[4 * gq + 2], St[4 * gq + 3]}; *(f32x4*)(so + 8 * gq + 4 * hhq) = v; }
        }
        { const int jl = k * 128 + 32 * jt + l31q, tl = dir ? L - 1 - jl : jl;
          bf16* yo = YD + (size_t)(row_base + tl) * 512 + h * 64 + 32 * q + 4 * hhq;
#pragma unroll
          for (int gq = 0; gq < 4; ++gq) { v2u o; o.x = pk2(Y[4 * gq], Y[4 * gq + 1]); o.y = pk2(Y[4 * gq + 2], Y[4 * gq + 3]); *(GAS v2u*)(yo + 8 * gq) = o; } }
    }
}

__device__ __forceinline__ void phase3(const Args& a, LAS unsigned char* lds, int tid, int lane, int wave, int vcu, int G) {
    if (G >= 256) {
        if (vcu < 128) { ssd_unit(a, lds, tid, lane, wave, 32 + (vcu >> 4), (vcu >> 1) & 7, vcu & 1); return; }
        for (int pu = vcu - 128; pu < 512; pu += G - 128) ssd_unit(a, lds, tid, lane, wave, pu >> 4, (pu >> 1) & 7, pu & 1);
    } else {
        for (int u = vcu; u < 640; u += G) { if (u < 128) ssd_unit(a, lds, tid, lane, wave, 32 + (u >> 4), (u >> 1) & 7, u & 1); else { const int pu = u - 128; ssd_unit(a, lds, tid, lane, wave, pu >> 4, (pu >> 1) & 7, pu & 1); } }
    }
}

__device__ __forceinline__ void phase3c(const Args& a, int lane, int gw, int NGW) {
    const bf16* PROJ = (const bf16*)(a.ws + WS_PROJ); const bf16* YD = (const bf16*)(a.ws + WS_YF); bf16* A3 = (bf16*)(a.ws + WS_A3);
    const float* g_ssd = a.in[17];
    const f32x4 g0 = *(const f32x4*)(g_ssd + 8 * lane), g1 = *(const f32x4*)(g_ssd + 8 * lane + 4);
    for (int rb = gw; rb < MTOK / 8; rb += NGW) {
        v4u yf[8], yb[8], zz[8];
#pragma unroll
        for (int rr = 0; rr < 8; ++rr) { const size_t row = (size_t)rb * 8 + rr;
            yf[rr] = *(const GAS v4u*)(YD + row * 512 + 8 * lane); yb[rr] = *(const GAS v4u*)(YD + (size_t)MTOK * 512 + row * 512 + 8 * lane); zz[rr] = *(const GAS v4u*)(PROJ + row * NPJ + 1536 + 8 * lane); }
#pragma unroll
        for (int rr = 0; rr < 8; ++rr) { const size_t row = (size_t)rb * 8 + rr;
            float yz[8]; float sq = 0.f;
#pragma unroll
            for (int e2 = 0; e2 < 4; ++e2) { yz[2 * e2] = (bflo(yf[rr][e2]) + bflo(yb[rr][e2])) * silu_f(bflo(zz[rr][e2])); yz[2 * e2 + 1] = (bfhi(yf[rr][e2]) + bfhi(yb[rr][e2])) * silu_f(bfhi(zz[rr][e2]));
                sq += yz[2 * e2] * yz[2 * e2] + yz[2 * e2 + 1] * yz[2 * e2 + 1]; }
            const float r = __builtin_amdgcn_rsqf(wave_sum(sq) * (1.0f / 512.0f) + EPS);
            v4u o; o.x = pk2((yz[0] * r) * g0[0], (yz[1] * r) * g0[1]); o.y = pk2((yz[2] * r) * g0[2], (yz[3] * r) * g0[3]); o.z = pk2((yz[4] * r) * g1[0], (yz[5] * r) * g1[1]); o.w = pk2((yz[6] * r) * g1[2], (yz[7] * r) * g1[3]);
            *(GAS v4u*)(A3 + row * 1024 + 8 * lane) = o; }
    }
}
template <bool LAT>
__device__ __forceinline__ void ffn_issue(const bf16* U, LAS unsigned char* lds, int T, int buf, int lane, int wave) {
    constexpr int NS = LAT ? 54 : 34, NTILE = LAT ? 5632 : 2816, BUFB = 55296;
    const int cgb = T / (NTILE / 11), rest = T % (NTILE / 11);
    const size_t coff = (size_t)(lane < 32 ? cgb * 256 + lane * 8 : DFF + cgb * 256 + (lane - 32) * 8);
    for (int sl = wave; sl < NS; sl += 8) {
        int r;
        if (LAT) { const int bq = rest >> 6, gr = (rest >> 2) & 15, cb = rest & 3; int rr = gr + sl / 18 - 1, cc = cb * 16 - 1 + sl % 18;
            if (rr < 0 || rr > 15 || cc < 0 || cc > 63) { rr = gr; cc = cb * 16; }
            r = bq * 1024 + rr * 64 + cc;
        } else { const int sq = rest >> 3, tb = rest & 7; int tt = tb * 32 - 1 + sl; if (tt < 0 || tt > 255) tt = tb * 32; r = sq * 256 + tt; }
        __builtin_amdgcn_global_load_lds((const unsigned*)(U + (size_t)r * NUP + coff), (LAS unsigned*)(lds + buf * BUFB + sl * 1024), 16, 0, 0);
    }
}
template <bool LAT>
__device__ __forceinline__ void conv_ffn(const Args& a, LAS unsigned char* lds, int half, int lane, int wave, int cu, int G) {
    constexpr int NS = LAT ? 54 : 34, TPW = LAT ? 2 : 4, NTAP = LAT ? 9 : 3, NTILE = LAT ? 5632 : 2816, BUFB = 55296;
    const bf16* U = (const bf16*)(a.ws + WS_U); bf16* Gb = (bf16*)(a.ws + WS_G) + (size_t)half * 8192 * DFF;
    const float* wf = a.in[20]; const float* bfc = a.in[21];
    const int T0 = (int)((long)cu * NTILE / G), T1 = (int)((long)(cu + 1) * NTILE / G);
    float w[NTAP][2][4], b[2][4]; int cgb_cur = -1;
    if (T0 < T1) ffn_issue<LAT>(U, lds, T0, 0, lane, wave);
    for (int T = T0; T < T1; ++T) {
        const int buf = (T - T0) & 1;
        VM_WAIT();
        __syncthreads();
        if (T + 1 < T1) ffn_issue<LAT>(U, lds, T + 1, buf ^ 1, lane, wave);
        const int cgb = T / (NTILE / 11), rest = T % (NTILE / 11), c = cgb * 256 + lane * 4;
        if (cgb != cgb_cur) { cgb_cur = cgb;
#pragma unroll
            for (int tp = 0; tp < NTAP; ++tp)
#pragma unroll
                for (int s = 0; s < 2; ++s) { const f32x4 v = *(const f32x4*)(wf + (size_t)(LAT ? tp : 3 + tp) * NUP + s * DFF + c); w[tp][s][0] = v[0]; w[tp][s][1] = v[1]; w[tp][s][2] = v[2]; w[tp][s][3] = v[3]; }
#pragma unroll
            for (int s = 0; s < 2; ++s) { const f32x4 v = *(const f32x4*)(bfc + s * DFF + c); b[s][0] = v[0]; b[s][1] = v[1]; b[s][2] = v[2]; b[s][3] = v[3]; }
        }
        LAS unsigned char* base = lds + buf * BUFB + lane * 8;
#pragma unroll
        for (int tt = 0; tt < TPW; ++tt) {
            const int o = wave * TPW + tt;
            float acc[2][4];
#pragma unroll
            for (int s = 0; s < 2; ++s)
#pragma unroll
                for (int e = 0; e < 4; ++e) acc[s][e] = b[s][e];
            int rout;
            if (LAT) { const int bq = rest >> 6, gr = (rest >> 2) & 15, cb = rest & 3, gc = cb * 16 + o; rout = bq * 1024 + gr * 64 + gc;
#pragma unroll
                for (int di = 0; di < 3; ++di)
#pragma unroll
                    for (int dj = 0; dj < 3; ++dj) { const int rr = gr + di - 1, c2 = gc + dj - 1;
                        if (rr >= 0 && rr < 16 && c2 >= 0 && c2 < 64) { const LAS unsigned char* sp = base + (di * 18 + o + dj) * 1024;
#pragma unroll
                            for (int s = 0; s < 2; ++s) { const v2u v = *(const LAS v2u*)(sp + s * 512);
                                acc[s][0] += w[di * 3 + dj][s][0] * bflo(v.x); acc[s][1] += w[di * 3 + dj][s][1] * bfhi(v.x); acc[s][2] += w[di * 3 + dj][s][2] * bflo(v.y); acc[s][3] += w[di * 3 + dj][s][3] * bfhi(v.y); } } }
            } else { const int sq = rest >> 3, tb = rest & 7, tk = tb * 32 + o; rout = sq * 256 + tk;
#pragma unroll
                for (int dj = 0; dj < 3; ++dj) { const int t2 = tk + dj - 1;
                    if (t2 >= 0 && t2 < 256) { const LAS unsigned char* sp = base + (o + dj) * 1024;
#pragma unroll
                        for (int s = 0; s < 2; ++s) { const v2u v = *(const LAS v2u*)(sp + s * 512);
                            acc[s][0] += w[dj][s][0] * bflo(v.x); acc[s][1] += w[dj][s][1] * bfhi(v.x); acc[s][2] += w[dj][s][2] * bflo(v.y); acc[s][3] += w[dj][s][3] * bfhi(v.y); } } }
            }
            v2u ov; ov.x = pk2(silu_f(acc[0][0]) * acc[1][0], silu_f(acc[0][1]) * acc[1][1]); ov.y = pk2(silu_f(acc[0][2]) * acc[1][2], silu_f(acc[0][3]) * acc[1][3]);
            *(GAS v2u*)(Gb + (size_t)rout * DFF + c) = ov;
        }
    }
    VM_WAIT();
    __syncthreads();
}
__device__ __forceinline__ void phase8(const Args& a, int lane, int gw, int NGW) {
    const float* ssq3 = (const float*)(a.ws + WS_CTL) + CW_SSQ3; const float* gf = a.in[23];
    f32x4 g4[4];
#pragma unroll
    for (int jj = 0; jj < 4; ++jj) g4[jj] = *(const f32x4*)(gf + 4 * lane + 256 * jj);
    for (int rb = gw; rb < MTOK / 8; rb += NGW)
        for (int rr = 0; rr < 8; ++rr) { const int row = rb * 8 + rr; float* xr = a.out + (size_t)row * 1024;
            const float r = __builtin_amdgcn_rsqf(ssq3[row] * (1.0f / 1024.0f) + EPS);
#pragma unroll
            for (int jj = 0; jj < 4; ++jj) { const f32x4 v = *(const f32x4*)(xr + 4 * lane + 256 * jj); *(f32x4*)(xr + 4 * lane + 256 * jj) = (v * r) * g4[jj]; } }
}

__global__ void __launch_bounds__(NTHR, 2) mega_fwd(Args a) {
    extern __shared__ __attribute__((aligned(16))) unsigned char lds_raw[];
    LAS unsigned char* lds = (LAS unsigned char*)lds_raw;
#define PH_IDS const int tid = opaque_i((int)threadIdx.x), lane = tid & 63, wave = __builtin_amdgcn_readfirstlane(tid >> 6); const int gw = vcu * NWAVES + wave; (void)gw; (void)lane;
    const int G = gridDim.x; const int bx = blockIdx.x; const int vcu = (G % 8 == 0) ? (bx % 8) * (G / 8) + bx / 8 : bx;
    const int NGW = G * NWAVES;
    unsigned* ctl = (unsigned*)(a.ws + WS_CTL); float* ctlf = (float*)ctl;
    for (int u = threadIdx.x; u < (LDS_BYTES - LDSCTL_OFF) / 4; u += NTHR) ((LAS unsigned*)(lds + LDSCTL_OFF))[u] = 0u;
    __syncthreads();
    XcdBarrier bar = xcd_barrier_post(ctl + CW_BAR, (volatile LAS unsigned*)(lds + LDSCTL_OFF + 64));
#ifdef PROBE_MASK
    unsigned long long pr_t = __builtin_amdgcn_s_memrealtime(), pr_extra = 0ull; int pr_seg = 0;
#define SEG_END() do { const unsigned long long t_ = __builtin_amdgcn_s_memrealtime(); if ((PROBE_MASK >> pr_seg) & 1) pr_extra += t_ - pr_t; pr_t = t_; ++pr_seg; } while (0)
#else
#define SEG_END() do { } while (0)
#endif

#ifndef NO_P0
    { PH_IDS phase0(a, lds, tid, lane, wave, vcu, G); }
#endif
    xcd_barrier(bar); SEG_END();
#ifndef NO_P1
    { PH_IDS phase1(a, lds, tid, lane, wave, vcu, G); }
#endif
    xcd_barrier(bar); SEG_END();
    {
        pg8::Gemm g{(const pg8::bf16_t*)(a.ws + WS_AX), (const pg8::bf16_t*)(a.ws + WS_WIN), MTOK, NPJ, 1024}; pg8::StaticOrder S; S.init(MTOK, NPJ, G, bx);
        pg8::EpiPlainBf16 E{(pg8::bf16_t*)(a.ws + WS_PROJ), NPJ};
#ifndef NO_G2
        pg8::gemm_phase<pg8::EpiPlainBf16, pg8::StaticOrder, true, true>(lds, g, S, E);
#endif
    }
    xcd_barrier(bar); SEG_END();
#ifndef NO_PXC
    { PH_IDS phase_xc(a, lane, gw, NGW); }
#endif
    xcd_barrier(bar); SEG_END();
#ifndef NO_P3
    { PH_IDS phase3(a, lds, tid, lane, wave, vcu, G); }
#endif
    xcd_barrier(bar); SEG_END();
    { PH_IDS phase3c(a, lane, gw, NGW); }
    xcd_barrier(bar); SEG_END();
    {
        pg8::Gemm g{(const pg8::bf16_t*)(a.ws + WS_A3), (const pg8::bf16_t*)(a.ws + WS_WOUT), MTOK, 1024, 1024}; pg8::StaticOrder S; S.init(MTOK, 1024, G, bx);
        pg8::EpiOut E{a.in[0], a.in[1], a.out, (pg8::bf16_t*)(a.ws + WS_AX), ctlf + CW_MOD, a.in[9], a.in[7], ctlf + CW_SSQ2, ctlf + CW_SSQY};
#ifndef NO_G4
        pg8::gemm_phase<pg8::EpiOut, pg8::StaticOrder, true, true>(lds, g, S, E);
#endif
    }
    xcd_barrier(bar); SEG_END();
    for (int half = 0; half < 2; ++half) {
        {
            pg8::Gemm g{(const pg8::bf16_t*)(a.ws + WS_AX) + (size_t)half * 8192 * 1024, (const pg8::bf16_t*)(a.ws + WS_WUP), 8192, NUP, 1024}; pg8::StaticOrder S; S.init(8192, NUP, G, bx);
            pg8::EpiUp E{(pg8::bf16_t*)(a.ws + WS_U), ctlf + CW_SSQ2, ctlf + CW_SV2, half * 32};
#ifndef NO_G5
            pg8::gemm_phase<pg8::EpiUp, pg8::StaticOrder, true, true>(lds, g, S, E);
#endif
        }
        xcd_barrier(bar); SEG_END();
#ifndef NO_P6
        { PH_IDS if (half == 0) conv_ffn<false>(a, lds, 0, lane, wave, vcu, G); else conv_ffn<true>(a, lds, 1, lane, wave, vcu, G); }
#endif
        xcd_barrier(bar); SEG_END();
    }
    {
        pg8::Gemm g{(const pg8::bf16_t*)(a.ws + WS_G), (const pg8::bf16_t*)(a.ws + WS_WDN), MTOK, 1024, DFF}; pg8::StaticOrder S; S.init(MTOK, 1024, G, bx);
        pg8::EpiDown E{a.out, ctlf + CW_MOD, a.in[9], ctlf + CW_SSQ3};
#ifndef NO_G7
        pg8::gemm_phase<pg8::EpiDown, pg8::StaticOrder, true, true>(lds, g, S, E);
#endif
    }
    xcd_barrier(bar); SEG_END();
#ifndef NO_P8
    { PH_IDS phase8(a, lane, gw, NGW); }
#endif
#ifdef PROBE_MASK
    SEG_END();
    if (blockIdx.x == 0 && threadIdx.x == 0) { const unsigned long long t0_ = __builtin_amdgcn_s_memrealtime(); while (__builtin_amdgcn_s_memrealtime() - t0_ < pr_extra) __builtin_amdgcn_s_sleep(8); }
#endif
}

extern "C" void kernel_launch(void* const* d_in, const int* in_sizes, int n_in, void* d_out, int out_size, void* d_ws, size_t ws_size, hipStream_t stream) {
    static int grid = 0;
    if (grid == 0) {
        if (n_in != 24 || ws_size < WS_END) { fprintf(stderr, "kernel_launch: unexpected problem (n_in %d, ws %zu)\n", n_in, ws_size); grid = -1; return; }
        int dev = 0, cus = 0, per_cu = 0;
        if (hipGetDevice(&dev) != hipSuccess || hipDeviceGetAttribute(&cus, hipDeviceAttributeMultiprocessorCount, dev) != hipSuccess) { grid = -1; return; }
        if (hipFuncSetAttribute((const void*)mega_fwd, hipFuncAttributeMaxDynamicSharedMemorySize, LDS_BYTES) != hipSuccess) { fprintf(stderr, "kernel_launch: hipFuncSetAttribute failed\n"); grid = -1; return; }
        if (hipOccupancyMaxActiveBlocksPerMultiprocessor(&per_cu, (const void*)mega_fwd, NTHR, LDS_BYTES) != hipSuccess || per_cu < 1) { fprintf(stderr, "kernel_launch: occupancy query says %d\n", per_cu); per_cu = 1; }
        (void)hipGetLastError();
        grid = cus;
    }
    if (grid < 0) return;
    (void)hipMemsetAsync((char*)d_ws + WS_CTL, 0, CTL_ZERO_BYTES, stream);
    Args a{};
    for (int i = 0; i < 24; ++i) a.in[i] = (const float*)d_in[i];
    a.out = (float*)d_out; a.ws = (unsigned char*)d_ws;
    hipLaunchKernelGGL(mega_fwd, dim3(grid), dim3(NTHR), LDS_BYTES, stream, a);
}
```
